# Optimizing an MI355X kernel written in HIP

```python
import math
import jax, jax.numpy as jnp
from jax import lax
import numpy as np

D_MODEL = 1024
BATCH = 16
SEQ = 2048
DEPTH = 2
DEC_BATCH = 8
DEC_SEQ = 8192
PAST_LEN = 128

N_HEADS = 16
N_KV_HEADS = 4
HEAD_DIM = D_MODEL // N_HEADS
Q_WIDTH = N_HEADS * HEAD_DIM
KV_WIDTH = N_KV_HEADS * HEAD_DIM
QKV_WIDTH = Q_WIDTH + 2 * KV_WIDTH
A_HALF_WINDOW = 128
A_BLOCK = 128
DILATED_GROUPS = ((128, 1), (512, 4), (2048, 16))
B_BLOCK = 64
NUM_BUCKETS = 32
MAX_DISTANCE = 1024
D_FF = ((8 * D_MODEL // 3 + 255) // 256) * 256
N_A_LAYERS = (DEPTH + 1) // 2
N_B_LAYERS = DEPTH // 2
EPS = 1e-6
NEG = -1e30

kernel_name = "hybrid_windowed_dilated_encoder"


def rms_norm(x, g):
    xf = x.astype(jnp.float32)
    y = xf * lax.rsqrt(jnp.mean(xf * xf, axis=-1, keepdims=True) + EPS)
    return (y * g.astype(jnp.float32)).astype(x.dtype)


def t5_buckets(rel):
    nb = NUM_BUCKETS // 2
    max_exact = nb // 2
    n = np.abs(rel)
    large = max_exact + (np.log(np.maximum(n, 1) / max_exact)
                         / math.log(MAX_DISTANCE / max_exact) * (nb - max_exact)).astype(np.int32)
    large = np.minimum(large, nb - 1)
    return ((rel > 0).astype(np.int32) * nb + np.where(n < max_exact, n, large)).astype(np.int32)


def relative_bias(rel_table, blk, dil):
    qi = np.arange(blk)[:, None]
    kj = np.arange(3 * blk)[None, :]
    buckets = t5_buckets(dil * (kj - blk - qi))
    return jnp.take(rel_table, jnp.asarray(buckets), axis=0).transpose(2, 0, 1).astype(jnp.float32)


def banded_attention(q, k, v, bias, blk, half_window, sink):
    N, L, H, Dh = q.shape
    G = k.shape[2]
    R = H // G
    nb = -(-L // blk)
    pad = nb * blk - L
    qp = jnp.pad(q, ((0, 0), (0, pad), (0, 0), (0, 0)))
    kp = jnp.pad(k, ((0, 0), (blk, blk + pad), (0, 0), (0, 0)))
    vp = jnp.pad(v, ((0, 0), (blk, blk + pad), (0, 0), (0, 0)))
    rel = np.arange(3 * blk)[None, :] - blk - np.arange(blk)[:, None]
    band = jnp.asarray(np.abs(rel) <= half_window)
    bias_g = bias.reshape(G, R, blk, 3 * blk)
    scale = Dh ** -0.5

    def one_block(n):
        start = n * blk
        qb = lax.dynamic_slice_in_dim(qp, start, blk, axis=1).reshape(N, blk, G, R, Dh).astype(jnp.float32)
        kb = lax.dynamic_slice_in_dim(kp, start, 3 * blk, axis=1).astype(jnp.float32)
        vb = lax.dynamic_slice_in_dim(vp, start, 3 * blk, axis=1).astype(jnp.float32)
        kpos = start - blk + jnp.arange(3 * blk)
        valid = jnp.logical_and(band, ((kpos >= 0) & (kpos < L))[None, :])
        s = jnp.einsum('nqgrd,nkgd->ngrqk', qb, kb) * scale + bias_g
        s = jnp.where(valid, s, NEG)
        lse = jax.nn.logsumexp(s, axis=-1)
        if sink is not None:
            lse = jnp.logaddexp(lse, sink.astype(jnp.float32).reshape(G, R)[None, :, :, None])
        p = jnp.exp(s - lse[..., None])
        o = jnp.einsum('ngrqk,nkgd->nqgrd', p, vb).reshape(N, blk, H, Dh)
        return o, lse.transpose(0, 3, 1, 2).reshape(N, blk, H)

    o, lse = lax.map(one_block, jnp.arange(nb))
    o = jnp.moveaxis(o, 0, 1).reshape(N, nb * blk, H, Dh)[:, :L]
    lse = jnp.moveaxis(lse, 0, 1).reshape(N, nb * blk, H)[:, :L]
    return o, lse


def split_heads(qkv_g, Bn, S):
    q = qkv_g[..., :Q_WIDTH].reshape(Bn, S, N_HEADS, HEAD_DIM)
    k = qkv_g[..., Q_WIDTH:Q_WIDTH + KV_WIDTH].reshape(Bn, S, N_KV_HEADS, HEAD_DIM)
    v = qkv_g[..., Q_WIDTH + KV_WIDTH:].reshape(Bn, S, N_KV_HEADS, HEAD_DIM)
    return q, k, v


def mixer_windowed(h, w_qkv, q_gain, k_gain, sink, w_o, rel_table):
    Bn, S, _ = h.shape
    q, k, v = split_heads(h @ w_qkv, Bn, S)
    q = rms_norm(q, q_gain)
    k = rms_norm(k, k_gain)
    bias = relative_bias(rel_table, A_BLOCK, 1)
    o, _ = banded_attention(q, k, v, bias, A_BLOCK, A_HALF_WINDOW, sink)
    return o.astype(h.dtype).reshape(Bn, S, Q_WIDTH) @ w_o


def mixer_dilated(h, w_qkv, q_gain, k_gain, w_o, rel_table):
    Bn, S, _ = h.shape
    qkv = h @ w_qkv
    outs, lses = [], []
    for gi, (window, dil) in enumerate(DILATED_GROUPS):
        q, k, v = split_heads(qkv[..., gi * QKV_WIDTH:(gi + 1) * QKV_WIDTH], Bn, S)
        q = rms_norm(q, q_gain[gi])
        k = rms_norm(k, k_gain[gi])
        Ls = S // dil
        fold = lambda t: t.reshape(Bn, Ls, dil, t.shape[2], HEAD_DIM).swapaxes(1, 2).reshape(Bn * dil, Ls, t.shape[2], HEAD_DIM)
        bias = relative_bias(rel_table, B_BLOCK, dil)
        o, lse = banded_attention(fold(q), fold(k), fold(v), bias, B_BLOCK, window // (2 * dil), None)
        outs.append(o.reshape(Bn, dil, Ls, N_HEADS, HEAD_DIM).swapaxes(1, 2).reshape(Bn, S, N_HEADS, HEAD_DIM))
        lses.append(lse.reshape(Bn, dil, Ls, N_HEADS).swapaxes(1, 2).reshape(Bn, S, N_HEADS))
    wts = jax.nn.softmax(jnp.stack(lses), axis=0)
    o = jnp.einsum('gbsh,gbshd->bshd', wts, jnp.stack(outs))
    return o.astype(h.dtype).reshape(Bn, S, Q_WIDTH) @ w_o


def swiglu(h, w_gate_up, w_down):
    gu = h @ w_gate_up
    return (jax.nn.silu(gu[..., :D_FF]) * gu[..., D_FF:]) @ w_down


def trunk(x, rel_table, norm_attn, norm_ffn, a_w_qkv, a_q_gain, a_k_gain, a_sink, a_w_o,
          b_w_qkv, b_q_gain, b_k_gain, b_w_o, ffn_w_gate_up, ffn_w_down):
    for i in range(DEPTH):
        h = rms_norm(x, norm_attn[i])
        j = i // 2
        if i % 2 == 0:
            x = x + mixer_windowed(h, a_w_qkv[j], a_q_gain[j], a_k_gain[j], a_sink[j], a_w_o[j], rel_table)
        else:
            x = x + mixer_dilated(h, b_w_qkv[j], b_q_gain[j], b_k_gain[j], b_w_o[j], rel_table)
        x = x + swiglu(rms_norm(x, norm_ffn[i]), ffn_w_gate_up[i], ffn_w_down[i])
    return x


def setup_inputs(seed: int = 0) -> dict:
    key = jax.random.key(seed)
    ks = jax.random.split(key, 16)
    f32 = jnp.float32
    nrm = lambda k, shape, s: jax.random.normal(k, shape, f32) * s
    n_grp = len(DILATED_GROUPS)
    return {
        "x_prompt": nrm(ks[0], (BATCH, SEQ, D_MODEL), 1.0),
        "x_sample": nrm(ks[1], (DEC_BATCH, DEC_SEQ, D_MODEL), 1.0),
        "rel_table": nrm(ks[2], (NUM_BUCKETS, N_HEADS), 0.5),
        "norm_attn": 1.0 + nrm(ks[3], (DEPTH, D_MODEL), 0.02),
        "norm_ffn": 1.0 + nrm(ks[4], (DEPTH, D_MODEL), 0.02),
        "a_w_qkv": nrm(ks[5], (N_A_LAYERS, D_MODEL, QKV_WIDTH), D_MODEL ** -0.5),
        "a_q_gain": 1.0 + nrm(ks[6], (N_A_LAYERS, HEAD_DIM), 0.02),
        "a_k_gain": 1.0 + nrm(ks[7], (N_A_LAYERS, HEAD_DIM), 0.02),
        "a_sink": nrm(ks[8], (N_A_LAYERS, N_HEADS), 1.0),
        "a_w_o": nrm(ks[9], (N_A_LAYERS, Q_WIDTH, D_MODEL), Q_WIDTH ** -0.5),
        "b_w_qkv": nrm(ks[10], (N_B_LAYERS, D_MODEL, n_grp * QKV_WIDTH), D_MODEL ** -0.5),
        "b_q_gain": 1.0 + nrm(ks[11], (N_B_LAYERS, n_grp, HEAD_DIM), 0.02),
        "b_k_gain": 1.0 + nrm(ks[12], (N_B_LAYERS, n_grp, HEAD_DIM), 0.02),
        "b_w_o": nrm(ks[13], (N_B_LAYERS, Q_WIDTH, D_MODEL), Q_WIDTH ** -0.5),
        "ffn_w_gate_up": nrm(ks[14], (DEPTH, D_MODEL, 2 * D_FF), D_MODEL ** -0.5),
        "ffn_w_down": nrm(ks[15], (DEPTH, D_FF, D_MODEL), D_FF ** -0.5),
    }


def reference(x_prompt, x_sample, rel_table, norm_attn, norm_ffn, a_w_qkv, a_q_gain, a_k_gain,
              a_sink, a_w_o, b_w_qkv, b_q_gain, b_k_gain, b_w_o, ffn_w_gate_up, ffn_w_down):
    y_prompt = trunk(x_prompt, rel_table, norm_attn, norm_ffn, a_w_qkv, a_q_gain, a_k_gain, a_sink, a_w_o,
                     b_w_qkv, b_q_gain, b_k_gain, b_w_o, ffn_w_gate_up, ffn_w_down)
    y_sample = trunk(x_sample, rel_table, norm_attn, norm_ffn, a_w_qkv, a_q_gain, a_k_gain, a_sink, a_w_o,
                     b_w_qkv, b_q_gain, b_k_gain, b_w_o, ffn_w_gate_up, ffn_w_down)
    return (y_prompt, y_sample)
```

```cpp
#include <hip/hip_runtime.h>
#include <hip/hip_cooperative_groups.h>
#include <cstdio>
#include <cstdint>
namespace cg = cooperative_groups;
namespace pg8 {
#define PG8_LAS __attribute__((address_space(3)))
typedef unsigned short bf16_t;
typedef short bf16x8 __attribute__((ext_vector_type(8)));
typedef float f32x4 __attribute__((ext_vector_type(4)));
typedef unsigned u32x4 __attribute__((ext_vector_type(4)));
constexpr int BM = 256, BK = 64, HALF = 128, HTB = HALF * BK * 2  , STAGE_BYTES = 8 * HTB, NXCD = 8, WGM = 8;

__host__ __device__ __forceinline__ int lds_byte(int r, int c) { const int st = (r >> 4) * 2 + (c >> 5), rr = r & 15, cc = c & 31, ob = rr * 64 + cc * 2; return st * 1024 + (ob ^ (((ob >> 9) & 1) << 5)); }
__host__ __device__ __forceinline__ void stage_rc(int b, int& R, int& C) { const int st = b / 1024, sb = b % 1024, swz = sb ^ (((sb >> 9) & 1) << 5); R = (st >> 1) * 16 + swz / 64; C = (st & 1) * 32 + (swz % 64) / 2; }
__host__ __device__ __forceinline__ int perm32(int rho) { const int n = rho >> 4, i = rho & 15; return 8 * (i >> 2) + 4 * n + (i & 3); }

struct Unit { int pm, pn; };
struct Gemm { const bf16_t* A; const bf16_t* Bt; int M, N, K; };

struct StaticOrder {
    int nM, nN, nwg, G, c;
    __host__ __device__ void init(int M, int N, int G_, int c_) { nM = M / BM; nN = N / BM; nwg = nM * nN; G = G_; c = c_; }
    __host__ __device__ bool next(int i, Unit& u) const {
        const long L = (long)i * G + c; if (L >= nwg) return false;
        int wgid = (int)L; { const int q = nwg / NXCD, r = nwg % NXCD, xcd = wgid % NXCD, off = wgid / NXCD; wgid = (xcd < r ? xcd * (q + 1) : r * (q + 1) + (xcd - r) * q) + off; }
        const int nig = WGM * nN, gid = wgid / nig, fm = gid * WGM, gsz = (nM - fm) < WGM ? (nM - fm) : WGM;
        u.pm = fm + ((wgid % nig) % gsz); u.pn = (wgid % nig) / gsz; return true;
    }
    __device__ __forceinline__ void a_ready(const Unit&) const {}
    __device__ __forceinline__ void done(const Unit&) const {}
};

typedef __bf16 bf16x2_hw __attribute__((ext_vector_type(2)));
typedef float f32x2_hw __attribute__((ext_vector_type(2)));
__device__ __forceinline__ unsigned cvt_pk_bf16(float lo, float hi) { f32x2_hw v = {lo, hi}; bf16x2_hw b = __builtin_convertvector(v, bf16x2_hw); return __builtin_bit_cast(unsigned, b); }

struct EpiBf16 {
    static constexpr bool PERM = true, AFTER_DRAIN = false;
    bf16_t* O; int ldc;
    __device__ __forceinline__ void operator()(const f32x4 (&acc)[2][2][4][2], const Unit& u, int wr, int wc, int fr, int fq) const {
        const int row0 = u.pm * BM + wr * 64 + fr; const int col0 = u.pn * BM + wc * 32 + 8 * fq;
#pragma unroll
        for (int ai = 0; ai < 2; ++ai)
#pragma unroll
            for (int m = 0; m < 4; ++m) { bf16_t* rowp = O + (size_t)(row0 + ai * HALF + m * 16) * ldc + col0;
#pragma unroll
                for (int bj = 0; bj < 2; ++bj) { const f32x4 v0 = acc[ai][bj][m][0], v1 = acc[ai][bj][m][1];
                    u32x4 w; w.x = cvt_pk_bf16(v0[0], v0[1]); w.y = cvt_pk_bf16(v0[2], v0[3]); w.z = cvt_pk_bf16(v1[0], v1[1]); w.w = cvt_pk_bf16(v1[2], v1[3]);
                    *(u32x4*)(rowp + bj * HALF) = w; } }
    }
};
struct EpiSwiglu {
    static constexpr bool PERM = true, AFTER_DRAIN = false;
    bf16_t* O; int ldc;
    __device__ __forceinline__ static float act(float g, float up) { return g * up * __builtin_amdgcn_rcpf(1.0f + __builtin_amdgcn_exp2f(-1.44269504089f * g)); }
    __device__ __forceinline__ void operator()(const f32x4 (&acc)[2][2][4][2], const Unit& u, int wr, int wc, int fr, int fq) const {
        const int row0 = u.pm * BM + wr * 64 + fr; const int col0 = u.pn * HALF + wc * 32 + 8 * fq;
#pragma unroll
        for (int ai = 0; ai < 2; ++ai)
#pragma unroll
            for (int m = 0; m < 4; ++m) { bf16_t* rowp = O + (size_t)(row0 + ai * HALF + m * 16) * ldc + col0;
                const f32x4 g0 = acc[ai][0][m][0], g1 = acc[ai][0][m][1], u0 = acc[ai][1][m][0], u1 = acc[ai][1][m][1];
                u32x4 w; w.x = cvt_pk_bf16(act(g0[0], u0[0]), act(g0[1], u0[1])); w.y = cvt_pk_bf16(act(g0[2], u0[2]), act(g0[3], u0[3]));
                w.z = cvt_pk_bf16(act(g1[0], u1[0]), act(g1[1], u1[1])); w.w = cvt_pk_bf16(act(g1[2], u1[2]), act(g1[3], u1[3]));
                *(u32x4*)rowp = w; }
    }
};
struct EpiResid {
    static constexpr bool PERM = true, AFTER_DRAIN = false;
    const float* base0; const float* base1; int split; float* out; int ldc;
    __device__ __forceinline__ void operator()(const f32x4 (&acc)[2][2][4][2], const Unit& u, int wr, int wc, int fr, int fq) const {
        const int row0 = u.pm * BM + wr * 64 + fr; const int col0 = u.pn * BM + wc * 32 + 8 * fq;
        const float* bb = (u.pm * BM < split) ? base0 : base1 - (size_t)split * ldc;
#pragma unroll
        for (int ai = 0; ai < 2; ++ai)
#pragma unroll
            for (int m = 0; m < 4; ++m) { const size_t off = (size_t)(row0 + ai * HALF + m * 16) * ldc + col0;
#pragma unroll
                for (int bj = 0; bj < 2; ++bj) {
                    const f32x4 b0 = *(const f32x4*)(bb + off + bj * HALF), b1 = *(const f32x4*)(bb + off + bj * HALF + 4);
                    *(f32x4*)(out + off + bj * HALF) = b0 + acc[ai][bj][m][0]; *(f32x4*)(out + off + bj * HALF + 4) = b1 + acc[ai][bj][m][1]; } }
    }
};


template <class Epi, class Sched, bool ALIGN_EPI = false, bool SP2 = false>
__device__ __forceinline__ void gemm_phase(PG8_LAS unsigned char* lds, const Gemm g, const Sched& S, const Epi& E, const int tid) {
    const int wid = __builtin_amdgcn_readfirstlane(tid >> 6), lane = tid & 63, wr = wid >> 2, wc = wid & 3, fr = lane & 15, fq = lane >> 4;
    const int K = g.K, nt = K / BK;
    unsigned voffA[2], voffB[2];
#pragma unroll
    for (int i = 0; i < 2; ++i) { int R, C; stage_rc(tid * 16 + i * 8192, R, C); const int Rb = Epi::PERM ? ((R & ~31) + perm32(R & 31)) : R;
        voffA[i] = (unsigned)(R * K + C) * 2u; voffB[i] = (unsigned)(Rb * K + C) * 2u; }
    const size_t kstep = (size_t)(BK * 2);
    const size_t hstep = (size_t)HALF * K * 2;
    const size_t tstep = 2 * hstep;
    const unsigned ldsw = (unsigned)wid * 1024u;
    const int aoff = lds_byte(wr * 64 + fr, fq * 8), boff = lds_byte(wc * 32 + fr, fq * 8);
#define PG8_SA(b, h) (((b) * 2 + (h)) * HTB)
#define PG8_SB(b, h) ((4 + (b) * 2 + (h)) * HTB)
#define PG8_STAGE(bufoff, gbase, voff) do { _Pragma("unroll") for (int _i = 0; _i < 2; ++_i) \
        __builtin_amdgcn_global_load_lds((const unsigned*)((const char*)(gbase) + (voff)[_i]), (PG8_LAS unsigned*)(lds + (bufoff) + ldsw + _i * 8192), 16, 0, 0); } while (0)
#define PG8_LDA(dst, b, h) do { _Pragma("unroll") for (int m = 0; m < 4; ++m) _Pragma("unroll") for (int k = 0; k < 2; ++k) dst[m][k] = *(const PG8_LAS bf16x8*)(lds + PG8_SA(b, h) + aoff + m * 2048 + k * 1024); } while (0)
#define PG8_LDB(dst, b, h) do { _Pragma("unroll") for (int n = 0; n < 2; ++n) _Pragma("unroll") for (int k = 0; k < 2; ++k) dst[n][k] = *(const PG8_LAS bf16x8*)(lds + PG8_SB(b, h) + boff + n * 2048 + k * 1024); } while (0)
#define PG8_MMA(ai, bj, At, Bt) do { __builtin_amdgcn_s_setprio(1); _Pragma("unroll") for (int m = 0; m < 4; ++m) _Pragma("unroll") for (int n = 0; n < 2; ++n) _Pragma("unroll") for (int k = 0; k < 2; ++k) \
        acc[ai][bj][m][n] = __builtin_amdgcn_mfma_f32_16x16x32_bf16(Bt[n][k], At[m][k], acc[ai][bj][m][n], 0, 0, 0); __builtin_amdgcn_s_setprio(0); } while (0)
#define PG8_WAIT_V(n) asm volatile("s_waitcnt vmcnt(" #n ")" ::: "memory")
#define PG8_WAIT_L(n) asm volatile("s_waitcnt lgkmcnt(" #n ")" ::: "memory")
#define PG8_BAR __builtin_amdgcn_s_barrier()
#define PG8_SCHED __builtin_amdgcn_sched_barrier(0)
    Unit cur, nxt; int ui = 0;
    if (!S.next(0, cur)) return;
    f32x4 acc[2][2][4][2];
#pragma unroll
    for (int a = 0; a < 2; ++a)
#pragma unroll
        for (int b = 0; b < 2; ++b)
#pragma unroll
            for (int m = 0; m < 4; ++m)
#pragma unroll
                for (int n = 0; n < 2; ++n) acc[a][b][m][n] = (f32x4){0.f, 0.f, 0.f, 0.f};
    bf16x8 At[4][2], B0[2][2], B1[2][2];
    const char* cA = (const char*)g.A + (size_t)cur.pm * tstep; const char* cB = (const char*)g.Bt + (size_t)cur.pn * tstep;
    S.a_ready(cur);
    if constexpr (SP2) {
        PG8_STAGE(PG8_SB(0, 0), cB, voffB); PG8_STAGE(PG8_SB(0, 1), cB + hstep, voffB); PG8_STAGE(PG8_SA(0, 0), cA, voffA); PG8_STAGE(PG8_SA(0, 1), cA + hstep, voffA);
        if (wr == 1) PG8_BAR;
        PG8_WAIT_V(2); PG8_BAR;
        PG8_STAGE(PG8_SB(1, 0), cB + kstep, voffB); PG8_STAGE(PG8_SA(1, 0), cA + kstep, voffA); PG8_STAGE(PG8_SB(1, 1), cB + hstep + kstep, voffB);
        PG8_WAIT_V(6); PG8_BAR;
    } else {
        PG8_STAGE(PG8_SB(0, 0), cB, voffB); PG8_STAGE(PG8_SA(0, 0), cA, voffA); PG8_STAGE(PG8_SB(0, 1), cB + hstep, voffB); PG8_STAGE(PG8_SA(0, 1), cA + hstep, voffA);
        if (wr == 1) PG8_BAR;
        PG8_WAIT_V(4); PG8_BAR;
        PG8_STAGE(PG8_SB(1, 0), cB + kstep, voffB); PG8_STAGE(PG8_SA(1, 0), cA + kstep, voffA); PG8_STAGE(PG8_SB(1, 1), cB + hstep + kstep, voffB);
        PG8_WAIT_V(6); PG8_BAR;
    }
    for (;;) {
        const bool has_next = S.next(ui + 1, nxt);
        const char* nA = has_next ? (const char*)g.A + (size_t)nxt.pm * tstep : cA; const char* nB = has_next ? (const char*)g.Bt + (size_t)nxt.pn * tstep : cB;
        for (int t = 0; t < nt; t += 2) {
            const bool last = (t == nt - 2);
            const char* a1 = cA + (size_t)(t + 1) * kstep;
            const char* a2 = last ? nA : cA + (size_t)(t + 2) * kstep; const char* b2 = last ? nB : cB + (size_t)(t + 2) * kstep;
            const char* a3 = a2 + kstep; const char* b3 = b2 + kstep;
            if (last && has_next) S.a_ready(nxt);
            if constexpr (SP2) {
            PG8_LDB(B0, 0, 0); PG8_LDB(B1, 0, 1); PG8_SCHED; PG8_LDA(At, 0, 0); PG8_STAGE(PG8_SA(1, 1), a1 + hstep, voffA);
            PG8_WAIT_V(8); PG8_WAIT_L(0); PG8_BAR; PG8_MMA(0, 0, At, B0); PG8_MMA(0, 1, At, B1); PG8_BAR; PG8_SCHED;
            PG8_LDA(At, 0, 1); PG8_STAGE(PG8_SB(0, 0), b2, voffB); PG8_STAGE(PG8_SB(0, 1), b2 + hstep, voffB); PG8_STAGE(PG8_SA(0, 0), a2, voffA);
            PG8_WAIT_V(8); PG8_WAIT_L(0); PG8_BAR; PG8_MMA(1, 0, At, B0); PG8_MMA(1, 1, At, B1); PG8_BAR; PG8_SCHED;
            PG8_LDB(B0, 1, 0); PG8_LDB(B1, 1, 1); PG8_SCHED; PG8_LDA(At, 1, 0); PG8_STAGE(PG8_SA(0, 1), a2 + hstep, voffA);
            PG8_WAIT_V(8); PG8_WAIT_L(0); PG8_BAR; PG8_MMA(0, 0, At, B0); PG8_MMA(0, 1, At, B1); PG8_BAR; PG8_SCHED;
            PG8_LDA(At, 1, 1); PG8_STAGE(PG8_SB(1, 0), b3, voffB); PG8_STAGE(PG8_SB(1, 1), b3 + hstep, voffB); PG8_STAGE(PG8_SA(1, 0), a3, voffA);
            PG8_WAIT_V(8); PG8_WAIT_L(0); PG8_BAR; PG8_MMA(1, 0, At, B0); PG8_MMA(1, 1, At, B1); PG8_BAR; PG8_SCHED;
            } else {
            PG8_LDB(B0, 0, 0); PG8_SCHED; PG8_LDA(At, 0, 0); PG8_STAGE(PG8_SA(1, 1), a1 + hstep, voffA);
            PG8_WAIT_L(8); PG8_BAR; PG8_WAIT_L(0); PG8_MMA(0, 0, At, B0); PG8_BAR; PG8_SCHED;
            PG8_LDB(B1, 0, 1); PG8_STAGE(PG8_SB(0, 0), b2, voffB);
            PG8_BAR; PG8_WAIT_L(0); PG8_MMA(0, 1, At, B1); PG8_BAR;
            PG8_LDA(At, 0, 1); PG8_STAGE(PG8_SA(0, 0), a2, voffA);
            PG8_BAR; PG8_WAIT_L(0); PG8_MMA(1, 0, At, B0); PG8_BAR; PG8_SCHED;
            PG8_STAGE(PG8_SB(0, 1), b2 + hstep, voffB);
            PG8_WAIT_V(6); PG8_BAR; PG8_MMA(1, 1, At, B1); PG8_BAR;
            PG8_LDB(B0, 1, 0); PG8_SCHED; PG8_LDA(At, 1, 0); PG8_STAGE(PG8_SA(0, 1), a2 + hstep, voffA);
            PG8_WAIT_L(8); PG8_BAR; PG8_WAIT_L(0); PG8_MMA(0, 0, At, B0); PG8_BAR; PG8_SCHED;
            PG8_LDB(B1, 1, 1); PG8_STAGE(PG8_SB(1, 0), b3, voffB);
            PG8_BAR; PG8_WAIT_L(0); PG8_MMA(0, 1, At, B1); PG8_BAR;
            PG8_LDA(At, 1, 1); PG8_STAGE(PG8_SA(1, 0), a3, voffA);
            PG8_BAR; PG8_WAIT_L(0); PG8_MMA(1, 0, At, B0); PG8_BAR; PG8_SCHED;
            PG8_STAGE(PG8_SB(1, 1), b3 + hstep, voffB);
            PG8_WAIT_V(6); PG8_BAR; PG8_MMA(1, 1, At, B1); PG8_BAR;
            }
        }
        if constexpr (ALIGN_EPI) { if (wr == 0) PG8_BAR; }
        if constexpr (!Epi::AFTER_DRAIN) { E(acc, cur, wr, wc, fr, fq); S.done(cur); }
        if (!has_next) break;
#pragma unroll
        for (int a = 0; a < 2; ++a)
#pragma unroll
            for (int b = 0; b < 2; ++b)
#pragma unroll
                for (int m = 0; m < 4; ++m)
#pragma unroll
                    for (int n = 0; n < 2; ++n) acc[a][b][m][n] = (f32x4){0.f, 0.f, 0.f, 0.f};
        cur = nxt; cA = nA; cB = nB; ++ui;
        if constexpr (ALIGN_EPI) { if (wr == 1) PG8_BAR; }
    }
    PG8_WAIT_V(0);
    if constexpr (!ALIGN_EPI) { if (wr == 0) PG8_BAR; }
    PG8_BAR;
    if constexpr (Epi::AFTER_DRAIN) { E.fused(acc, cur, wr, wc, fr, fq, lds, wid, lane); S.done(cur); }
#undef PG8_SA
#undef PG8_SB
#undef PG8_STAGE
#undef PG8_LDA
#undef PG8_LDB
#undef PG8_MMA
#undef PG8_WAIT_V
#undef PG8_WAIT_L
#undef PG8_BAR
#undef PG8_SCHED
}
}

constexpr int NWAVES = 8;
constexpr int D = 1024, DFF = 2816, NQKV = 1536;
constexpr int ROWS_P = 16 * 2048, ROWS_S = 8 * 8192, M = ROWS_P + ROWS_S;
constexpr float EPS = 1e-6f, LOG2E = 1.44269504089f;
#ifndef MK_SINGLE
#define MK_SINGLE 1
#endif
constexpr int NPHASES = 18;

constexpr size_t MiB = 1u << 20;
constexpr size_t WS_WQKVA = 2 * MiB;
constexpr size_t WS_WOA   = 5 * MiB;
constexpr size_t WS_WQKVB = 7 * MiB;
constexpr size_t WS_WOB   = 16 * MiB;
constexpr size_t WS_WGU   = 18 * MiB;
constexpr size_t WS_WDN   = 40 * MiB;
constexpr size_t WS_H     = 64 * MiB;
constexpr size_t WS_QKV   = 256 * MiB;
constexpr size_t WS_O0    = 544 * MiB;
constexpr size_t WS_O1    = 736 * MiB;
constexpr size_t WS_LSE   = 928 * MiB;
constexpr size_t WS_ACT   = 256 * MiB;
constexpr size_t WS_END   = 944 * MiB;
static_assert(WS_ACT + (size_t)M * DFF * 2 <= WS_LSE && WS_LSE + (size_t)2 * M * 16 * 4 <= WS_END, "ws map");

constexpr int LDS_BYTES = 147456;

#define LAS __attribute__((address_space(3)))
typedef unsigned short bf16;
typedef float f32x4 __attribute__((ext_vector_type(4)));
typedef float f32x16 __attribute__((ext_vector_type(16)));
typedef short bf16x8 __attribute__((ext_vector_type(8)));
typedef short s16x4 __attribute__((ext_vector_type(4)));
typedef unsigned u32x4 __attribute__((ext_vector_type(4)));
typedef unsigned u32x2 __attribute__((ext_vector_type(2)));
using pg8::cvt_pk_bf16;
__device__ __forceinline__ float bf2f(short s) { return __builtin_bit_cast(float, (unsigned)(unsigned short)s << 16); }
__device__ __forceinline__ float wave_sum(float v) {
#pragma unroll
    for (int o = 1; o < 64; o <<= 1) v += __shfl_xor(v, o);
    return v;
}

struct Args { const float* in[16]; float* out; unsigned char* ws; int ph_lo, ph_hi; };

__device__ __forceinline__ void transpose_item(const float* W, int K, int N, bf16* WT, int k0, int n0, int drow0, LAS float* scr, int lane) {
#pragma unroll 8
    for (int i = 0; i < 32; ++i) { const int kk = 2 * i + (lane >> 5); scr[kk * 33 + (lane & 31)] = W[(size_t)(k0 + kk) * N + n0 + (lane & 31)]; }
    asm volatile("s_waitcnt lgkmcnt(0)" ::: "memory");
    const int c = lane & 7;
#pragma unroll
    for (int j = 0; j < 4; ++j) { const int n = (lane >> 3) + 8 * j; const LAS float* s = scr + (8 * c) * 33 + n;
        u32x4 o; o.x = cvt_pk_bf16(s[0 * 33], s[1 * 33]); o.y = cvt_pk_bf16(s[2 * 33], s[3 * 33]); o.z = cvt_pk_bf16(s[4 * 33], s[5 * 33]); o.w = cvt_pk_bf16(s[6 * 33], s[7 * 33]);
        *(u32x4*)(WT + (size_t)(drow0 + n) * K + k0 + 8 * c) = o; }
    asm volatile("s_waitcnt lgkmcnt(0)" ::: "memory");
}
__device__ __forceinline__ void prologue_weights(const Args& a, LAS unsigned char* lds, int gw, int NGW, int wave, int lane) {
    LAS float* scr = (LAS float*)(lds + wave * 16384);
    unsigned char* ws = a.ws;
    constexpr int I_QA = 16 * 48, I_O = 16 * 32, I_QB = 16 * 144, I_GU = 16 * 176, I_DN = 44 * 32;
    constexpr int NITEMS = I_QA + I_O + I_QB + I_O + 2 * I_GU + 2 * I_DN;
    for (int it = gw; it < NITEMS; it += NGW) {
        int r = it;
        if (r < I_QA) { transpose_item(a.in[5], D, NQKV, (bf16*)(ws + WS_WQKVA), 64 * (r / 48), 32 * (r % 48), 32 * (r % 48), scr, lane); continue; } r -= I_QA;
        if (r < I_O)  { transpose_item(a.in[9], D, D, (bf16*)(ws + WS_WOA), 64 * (r / 32), 32 * (r % 32), 32 * (r % 32), scr, lane); continue; } r -= I_O;
        if (r < I_QB) { transpose_item(a.in[10], D, 3 * NQKV, (bf16*)(ws + WS_WQKVB), 64 * (r / 144), 32 * (r % 144), 32 * (r % 144), scr, lane); continue; } r -= I_QB;
        if (r < I_O)  { transpose_item(a.in[13], D, D, (bf16*)(ws + WS_WOB), 64 * (r / 32), 32 * (r % 32), 32 * (r % 32), scr, lane); continue; } r -= I_O;
        if (r < 2 * I_GU) { const int l = r / I_GU; r -= l * I_GU; const int n0 = 32 * (r % 176); const int f = n0 < DFF ? n0 : n0 - DFF;
            const int drow = 256 * (f / 128) + (n0 < DFF ? 0 : 128) + (f % 128);
            transpose_item(a.in[14] + (size_t)l * D * 2 * DFF, D, 2 * DFF, (bf16*)(ws + WS_WGU) + (size_t)l * 2 * DFF * D, 64 * (r / 176), n0, drow, scr, lane); continue; } r -= 2 * I_GU;
        { const int l = r / I_DN; r -= l * I_DN;
            transpose_item(a.in[15] + (size_t)l * DFF * D, DFF, D, (bf16*)(ws + WS_WDN) + (size_t)l * D * DFF, 64 * (r / 32), 32 * (r % 32), 32 * (r % 32), scr, lane); }
    }
}
__device__ __forceinline__ void norm_phase(const float* x0, const float* x1, const float* g, bf16* H, int gw, int NGW, int lane) {
    f32x4 gv[4];
#pragma unroll
    for (int j = 0; j < 4; ++j) gv[j] = *(const f32x4*)(g + 4 * lane + 256 * j);
    for (int m = gw; m < M; m += NGW) {
        const float* xr = (m < ROWS_P) ? x0 + (size_t)m * D : x1 + (size_t)(m - ROWS_P) * D;
        f32x4 v[4]; float s = 0.f;
#pragma unroll
        for (int j = 0; j < 4; ++j) { v[j] = *(const f32x4*)(xr + 4 * lane + 256 * j); s += (v[j].x * v[j].x + v[j].y * v[j].y) + (v[j].z * v[j].z + v[j].w * v[j].w); }
        const float rstd = 1.0f / sqrtf(wave_sum(s) * (1.0f / D) + EPS);
        bf16* orow = H + (size_t)m * D + 4 * lane;
#pragma unroll
        for (int j = 0; j < 4; ++j) { const f32x4 t = v[j] * rstd * gv[j]; u32x2 o; o.x = cvt_pk_bf16(t.x, t.y); o.y = cvt_pk_bf16(t.z, t.w); *(u32x2*)(orow + 256 * j) = o; }
    }
}

template <int HW, int MODE>
__device__ __forceinline__ void attn_phase(LAS unsigned char* lds, const bf16* __restrict__ QKV, bf16* O, const bf16* P1, float* LSEw, const float* LSE0, const float* LSE1,
                                           int dsh, const float* gq, const float* gk, const float* sink, const float* rel_table, int G, int bid, const int tid) {
    constexpr int NK = 64 + 2 * HW, KST = 144, VST = NK * 2 + 8, TBN = 2 * HW + 64, NPASS = NK / 64;
    constexpr int KS_OFF = 0, VT_OFF = NK * KST, TB_OFF = VT_OFF + 64 * VST;
    static_assert(TB_OFF + 4 * TBN * 4 <= 131072, "attention LDS");
    const int lane = tid & 63, w = __builtin_amdgcn_readfirstlane(tid >> 6), hh = w >> 1, half = w & 1;
    const int ql = lane & 31, g2 = lane >> 5;
    const int skk = tid >> 3, sdc = tid & 7;
    float gkr[8];
#pragma unroll
    for (int i = 0; i < 8; ++i) gkr[i] = gk[sdc * 8 + i];
    LAS float* Tb = (LAS float*)(lds + TB_OFF);
    constexpr int NU = (16 * 32 + 8 * 128) * 4;
    for (int u = bid; u < NU; u += G) {
        const int kvh = u & 3, tile = u >> 2;
        int seq_row0, lsh, tin;
        if (tile < 512) { seq_row0 = (tile >> 5) * 2048; lsh = 11; tin = tile & 31; }
        else { const int t2 = tile - 512; seq_row0 = ROWS_P + (t2 >> 7) * 8192; lsh = 13; tin = t2 & 127; }
        const int Ls = 1 << (lsh - dsh), tsh = lsh - dsh - 6;
        const int r = tin >> tsh, t0 = (tin & ((1 << tsh) - 1)) * 64;
        const bf16* base = QKV + (size_t)(seq_row0 + r) * NQKV;
        bf16x8 kraw[NPASS], vraw[NPASS];
#pragma unroll
        for (int p = 0; p < NPASS; ++p) {
            const int t = t0 - HW + p * 64 + skk;
            kraw[p] = (bf16x8){0, 0, 0, 0, 0, 0, 0, 0}; vraw[p] = kraw[p];
            if (t >= 0 && t < Ls) { const bf16* rp = base + ((size_t)t << dsh) * NQKV + D + kvh * 64 + sdc * 8; kraw[p] = *(const bf16x8*)rp; vraw[p] = *(const bf16x8*)(rp + 256); }
        }
        const int h = kvh * 4 + hh;
        const int rowq = seq_row0 + r + ((t0 + 32 * half + ql) << dsh);
        bf16x8 qf[4];
        {
            const bf16* qp = QKV + (size_t)rowq * NQKV + h * 64 + 8 * g2;
            bf16x8 qr[4]; float ss = 0.f;
#pragma unroll
            for (int ks = 0; ks < 4; ++ks) { qr[ks] = *(const bf16x8*)(qp + 16 * ks);
#pragma unroll
                for (int j = 0; j < 8; ++j) { const float f = bf2f(qr[ks][j]); ss += f * f; } }
            ss += __shfl_xor(ss, 32);
            const float rs = (1.0f / sqrtf(ss * (1.0f / 64.0f) + EPS)) * (0.125f * LOG2E);
#pragma unroll
            for (int ks = 0; ks < 4; ++ks) { const float* gp = gq + 16 * ks + 8 * g2; u32x4 pk;
                pk.x = cvt_pk_bf16(bf2f(qr[ks][0]) * rs * gp[0], bf2f(qr[ks][1]) * rs * gp[1]); pk.y = cvt_pk_bf16(bf2f(qr[ks][2]) * rs * gp[2], bf2f(qr[ks][3]) * rs * gp[3]);
                pk.z = cvt_pk_bf16(bf2f(qr[ks][4]) * rs * gp[4], bf2f(qr[ks][5]) * rs * gp[5]); pk.w = cvt_pk_bf16(bf2f(qr[ks][6]) * rs * gp[6], bf2f(qr[ks][7]) * rs * gp[7]);
                qf[ks] = __builtin_bit_cast(bf16x8, pk); }
        }
        for (int e = tid; e < 4 * TBN; e += NWAVES * 64) {
            const int hq = e / TBN, idx = e - hq * TBN, rel = idx - 31 - HW; float v = -1e30f;
            if (rel >= -HW && rel <= HW) { const int off = rel * (1 << dsh), n = off < 0 ? -off : off;
                int b = n < 8 ? n : (n < 15 ? 8 : n < 27 ? 9 : n < 50 ? 10 : n < 91 ? 11 : n < 166 ? 12 : n < 305 ? 13 : n < 559 ? 14 : 15);
                b += off > 0 ? 16 : 0; v = rel_table[b * 16 + kvh * 4 + hq] * LOG2E; }
            Tb[e] = v; }
#pragma unroll
        for (int p = 0; p < NPASS; ++p) {
            const int kk = p * 64 + skk; float f[8]; float ss = 0.f;
#pragma unroll
            for (int j = 0; j < 8; ++j) { f[j] = bf2f(kraw[p][j]); ss += f[j] * f[j]; }
            ss += __shfl_xor(ss, 1); ss += __shfl_xor(ss, 2); ss += __shfl_xor(ss, 4);
            const float rs = 1.0f / sqrtf(ss * (1.0f / 64.0f) + EPS);
            u32x4 pk; pk.x = cvt_pk_bf16(f[0] * rs * gkr[0], f[1] * rs * gkr[1]); pk.y = cvt_pk_bf16(f[2] * rs * gkr[2], f[3] * rs * gkr[3]);
            pk.z = cvt_pk_bf16(f[4] * rs * gkr[4], f[5] * rs * gkr[5]); pk.w = cvt_pk_bf16(f[6] * rs * gkr[6], f[7] * rs * gkr[7]);
            *(LAS u32x4*)(lds + KS_OFF + kk * KST + sdc * 16) = pk;
#pragma unroll
            for (int j = 0; j < 8; ++j) *(LAS short*)(lds + VT_OFF + (sdc * 8 + j) * VST + kk * 2) = vraw[p][j];
        }
        __syncthreads();
        f32x16 o0, o1;
#pragma unroll
        for (int i = 0; i < 16; ++i) { o0[i] = 0.f; o1[i] = 0.f; }
        float mrun = -1e30f, lsum = 0.f;
        for (int c = half; c <= half + HW / 16; ++c) {
            const int tb = t0 - HW + 32 * c;
            if (tb < 0 || tb >= Ls) continue;
            f32x16 s;
#pragma unroll
            for (int i = 0; i < 16; ++i) s[i] = 0.f;
#pragma unroll
            for (int ks = 0; ks < 4; ++ks) { const bf16x8 a = *(const LAS bf16x8*)(lds + KS_OFF + (32 * c + ql) * KST + (16 * ks + 8 * g2) * 2);
                s = __builtin_amdgcn_mfma_f32_32x32x16_bf16(a, qf[ks], s, 0, 0, 0); }
            const LAS float* tp = Tb + hh * TBN + 32 * (c - half) + 31 - ql + 4 * g2;
            float mx = -1e30f;
#pragma unroll
            for (int i = 0; i < 16; ++i) { s[i] += tp[8 * (i >> 2) + (i & 3)]; mx = fmaxf(mx, s[i]); }
            mx = fmaxf(mx, __shfl_xor(mx, 32));
            const float mn = fmaxf(mrun, mx), alpha = __builtin_amdgcn_exp2f(mrun - mn); mrun = mn;
            float rsum = 0.f;
#pragma unroll
            for (int i = 0; i < 16; ++i) { s[i] = __builtin_amdgcn_exp2f(s[i] - mn); rsum += s[i]; }
            lsum = lsum * alpha + rsum;
#pragma unroll
            for (int i = 0; i < 16; ++i) { o0[i] *= alpha; o1[i] *= alpha; }
            u32x4 pa, pb;
            pa.x = cvt_pk_bf16(s[0], s[1]); pa.y = cvt_pk_bf16(s[2], s[3]); pa.z = cvt_pk_bf16(s[4], s[5]); pa.w = cvt_pk_bf16(s[6], s[7]);
            pb.x = cvt_pk_bf16(s[8], s[9]); pb.y = cvt_pk_bf16(s[10], s[11]); pb.z = cvt_pk_bf16(s[12], s[13]); pb.w = cvt_pk_bf16(s[14], s[15]);
            const bf16x8 p0 = __builtin_bit_cast(bf16x8, pa), p1 = __builtin_bit_cast(bf16x8, pb);
            const LAS unsigned char* vp = lds + VT_OFF + ql * VST + (32 * c + 4 * g2) * 2;
#pragma unroll
            for (int mt = 0; mt < 2; ++mt) {
                const s16x4 a00 = *(const LAS s16x4*)(vp + mt * 32 * VST), a01 = *(const LAS s16x4*)(vp + mt * 32 * VST + 16);
                const s16x4 a10 = *(const LAS s16x4*)(vp + mt * 32 * VST + 32), a11 = *(const LAS s16x4*)(vp + mt * 32 * VST + 48);
                const bf16x8 v0 = __builtin_shufflevector(a00, a01, 0, 1, 2, 3, 4, 5, 6, 7), v1 = __builtin_shufflevector(a10, a11, 0, 1, 2, 3, 4, 5, 6, 7);
                if (mt == 0) { o0 = __builtin_amdgcn_mfma_f32_32x32x16_bf16(v0, p0, o0, 0, 0, 0); o0 = __builtin_amdgcn_mfma_f32_32x32x16_bf16(v1, p1, o0, 0, 0, 0); }
                else         { o1 = __builtin_amdgcn_mfma_f32_32x32x16_bf16(v0, p0, o1, 0, 0, 0); o1 = __builtin_amdgcn_mfma_f32_32x32x16_bf16(v1, p1, o1, 0, 0, 0); }
            }
        }
        lsum += __shfl_xor(lsum, 32);
        if (MODE == 0) lsum += __builtin_amdgcn_exp2f(sink[h] * LOG2E - mrun);
        float f0 = 0.f, f1 = 0.f, f2 = 1.0f / lsum;
        if (MODE == 1) { if (g2 == 0) LSEw[(size_t)rowq * 16 + h] = mrun + __builtin_amdgcn_logf(lsum); }
        if (MODE == 2) {
            const float l2 = mrun + __builtin_amdgcn_logf(lsum), l0 = LSE0[(size_t)rowq * 16 + h], l1 = LSE1[(size_t)rowq * 16 + h];
            const float mm = fmaxf(l2, fmaxf(l0, l1)), w0 = __builtin_amdgcn_exp2f(l0 - mm), w1 = __builtin_amdgcn_exp2f(l1 - mm), w2 = __builtin_amdgcn_exp2f(l2 - mm);
            const float iw = 1.0f / (w0 + w1 + w2); f0 = w0 * iw; f1 = w1 * iw; f2 = w2 * iw / lsum;
        }
        bf16* op = O + (size_t)rowq * D + h * 64 + 4 * g2;
        const bf16* pp = P1 + (size_t)rowq * D + h * 64 + 4 * g2;
#pragma unroll
        for (int mt = 0; mt < 2; ++mt)
#pragma unroll
            for (int q4 = 0; q4 < 4; ++q4) {
                float v[4];
#pragma unroll
                for (int j = 0; j < 4; ++j) v[j] = (mt == 0 ? o0[4 * q4 + j] : o1[4 * q4 + j]) * f2;
                if (MODE == 2) { const s16x4 a = *(const s16x4*)(op + mt * 32 + 8 * q4), b = *(const s16x4*)(pp + mt * 32 + 8 * q4);
#pragma unroll
                    for (int j = 0; j < 4; ++j) v[j] += f0 * bf2f(a[j]) + f1 * bf2f(b[j]); }
                u32x2 o; o.x = cvt_pk_bf16(v[0], v[1]); o.y = cvt_pk_bf16(v[2], v[3]);
                *(u32x2*)(op + mt * 32 + 8 * q4) = o;
            }
        __syncthreads();
    }
}

__global__ void __launch_bounds__(NWAVES * 64, 2) fwd_megakernel(Args a) {
    extern __shared__ __attribute__((aligned(16))) unsigned char lds_raw[];
    LAS unsigned char* lds = (LAS unsigned char*)lds_raw;
    cg::grid_group grid = cg::this_grid();
    const int G = gridDim.x, bid = blockIdx.x;
    unsigned char* ws = a.ws;
    bf16* H = (bf16*)(ws + WS_H); bf16* QKV = (bf16*)(ws + WS_QKV); bf16* O0 = (bf16*)(ws + WS_O0); bf16* O1 = (bf16*)(ws + WS_O1); bf16* ACT = (bf16*)(ws + WS_ACT);
    float* LSE0 = (float*)(ws + WS_LSE); float* LSE1 = LSE0 + (size_t)M * 16;
    const float* xin0 = a.in[0]; const float* xin1 = a.in[1]; float* out = a.out;

    for (int ph = a.ph_lo; ph < a.ph_hi; ++ph) {
        int tid = threadIdx.x; asm volatile("" : "+v"(tid));
        const int lane = tid & 63, wave = __builtin_amdgcn_readfirstlane(tid >> 6), gw = bid * NWAVES + wave, NGW = G * NWAVES;
        if (ph == 0) { prologue_weights(a, lds, gw, NGW, wave, lane); norm_phase(xin0, xin1, a.in[3], H, gw, NGW, lane); }
        else if (ph == 4 || ph == 7 || ph == 15) {
            const float* g = ph == 4 ? a.in[4] : ph == 7 ? a.in[3] + D : a.in[4] + D;
            norm_phase(out, out + (size_t)ROWS_P * D, g, H, gw, NGW, lane);
        }
        else if (ph == 1 || ph == 8 || ph == 10 || ph == 12) {
            const bf16* Bt = ph == 1 ? (const bf16*)(ws + WS_WQKVA) : (const bf16*)(ws + WS_WQKVB) + (size_t)((ph - 8) >> 1) * NQKV * D;
            pg8::Gemm g{H, Bt, M, NQKV, D}; pg8::StaticOrder S; S.init(M, NQKV, G, bid);
            pg8::EpiBf16 E{QKV, NQKV};
            pg8::gemm_phase<pg8::EpiBf16, pg8::StaticOrder, true, true>(lds, g, S, E, tid);
        }
        else if (ph == 2) attn_phase<128, 0>(lds, QKV, O0, nullptr, nullptr, nullptr, nullptr, 0, a.in[6], a.in[7], a.in[8], a.in[2], G, bid, tid);
        else if (ph == 9 || ph == 11) {
            const int gi = (ph - 9) >> 1;
            attn_phase<64, 1>(lds, QKV, gi ? O1 : O0, nullptr, gi ? LSE1 : LSE0, nullptr, nullptr, 2 * gi, a.in[11] + 64 * gi, a.in[12] + 64 * gi, nullptr, a.in[2], G, bid, tid);
        }
        else if (ph == 13) attn_phase<64, 2>(lds, QKV, O0, O1, nullptr, LSE0, LSE1, 4, a.in[11] + 128, a.in[12] + 128, nullptr, a.in[2], G, bid, tid);
        else if (ph == 3 || ph == 14 || ph == 6 || ph == 17) {
            const bool isdown = (ph == 6 || ph == 17);
            const bf16* A = isdown ? ACT : O0;
            const bf16* Bt = ph == 3 ? (const bf16*)(ws + WS_WOA) : ph == 14 ? (const bf16*)(ws + WS_WOB) : (const bf16*)(ws + WS_WDN) + (size_t)(ph == 17 ? 1 : 0) * D * DFF;
            pg8::Gemm g{A, Bt, M, D, isdown ? DFF : D}; pg8::StaticOrder S; S.init(M, D, G, bid);
            pg8::EpiResid E{ph == 3 ? xin0 : out, ph == 3 ? xin1 : out + (size_t)ROWS_P * D, ROWS_P, out, D};
            pg8::gemm_phase<pg8::EpiResid, pg8::StaticOrder, true, true>(lds, g, S, E, tid);
        }
        else {
            const bf16* Bt = (const bf16*)(ws + WS_WGU) + (size_t)(ph == 16 ? 1 : 0) * 2 * DFF * D;
            pg8::Gemm g{H, Bt, M, 2 * DFF, D}; pg8::StaticOrder S; S.init(M, 2 * DFF, G, bid);
            pg8::EpiSwiglu E{ACT, DFF};
            pg8::gemm_phase<pg8::EpiSwiglu, pg8::StaticOrder, true, true>(lds, g, S, E, tid);
        }
        if (ph + 1 < a.ph_hi) grid.sync();
    }
}

extern "C" void kernel_launch(void* const* d_in, const int* in_sizes, int n_in, void* d_out, int out_size, void* d_ws, size_t ws_size, hipStream_t stream) {
    static int grid = 0;
    if (grid == 0) {
        if (n_in != 16 || out_size != M * D || ws_size < WS_END) { fprintf(stderr, "kernel_launch: unexpected shapes (n_in %d out %d ws %zu)\n", n_in, out_size, ws_size); grid = -1; return; }
        int dev = 0, cus = 0, per_cu = 0;
        hipGetDevice(&dev); hipDeviceGetAttribute(&cus, hipDeviceAttributeMultiprocessorCount, dev);
        if (hipFuncSetAttribute((const void*)fwd_megakernel, hipFuncAttributeMaxDynamicSharedMemorySize, LDS_BYTES) != hipSuccess) { fprintf(stderr, "kernel_launch: hipFuncSetAttribute failed\n"); grid = -1; return; }
        hipOccupancyMaxActiveBlocksPerMultiprocessor(&per_cu, (const void*)fwd_megakernel, NWAVES * 64, LDS_BYTES);
        if (per_cu < 1) { fprintf(stderr, "kernel_launch: occupancy query says %d blocks/CU\n", per_cu); per_cu = 1; }
        (void)hipGetLastError();
        grid = cus;
    }
    if (grid < 0) return;
    Args a{};
    for (int i = 0; i < 16; ++i) a.in[i] = (const float*)d_in[i];
    a.out = (float*)d_out; a.ws = (unsigned char*)d_ws;
#if MK_SINGLE
    a.ph_lo = 0; a.ph_hi = NPHASES;
    void* kargs[] = {&a};
    hipError_t e = hipLaunchCooperativeKernel((const void*)fwd_megakernel, dim3(grid), dim3(NWAVES * 64), kargs, LDS_BYTES, stream);
    if (e != hipSuccess) fprintf(stderr, "kernel_launch: cooperative launch failed: %s (grid %d)\n", hipGetErrorString(e), grid);
#else
    for (int ph = 0; ph < NPHASES; ++ph) { a.ph_lo = ph; a.ph_hi = ph + 1; hipLaunchKernelGGL(fwd_megakernel, dim3(grid), dim3(NWAVES * 64), LDS_BYTES, stream, a); }
#endif
}
```

```cpp
#include <hip/hip_runtime.h>
#include <hip/hip_cooperative_groups.h>
#include <cstdio>
#include <cstdint>
namespace cg = cooperative_groups;
namespace pg8 {
#define PG8_LAS __attribute__((address_space(3)))
typedef unsigned short bf16_t;
typedef short bf16x8 __attribute__((ext_vector_type(8)));
typedef float f32x4 __attribute__((ext_vector_type(4)));
typedef unsigned u32x4 __attribute__((ext_vector_type(4)));
constexpr int BM = 256, BK = 64, HALF = 128, HTB = HALF * BK * 2  , STAGE_BYTES = 8 * HTB, NXCD = 8, WGM = 8;

__host__ __device__ __forceinline__ int lds_byte(int r, int c) { const int st = (r >> 4) * 2 + (c >> 5), rr = r & 15, cc = c & 31, ob = rr * 64 + cc * 2; return st * 1024 + (ob ^ (((ob >> 9) & 1) << 5)); }
__host__ __device__ __forceinline__ void stage_rc(int b, int& R, int& C) { const int st = b / 1024, sb = b % 1024, swz = sb ^ (((sb >> 9) & 1) << 5); R = (st >> 1) * 16 + swz / 64; C = (st & 1) * 32 + (swz % 64) / 2; }
__host__ __device__ __forceinline__ int perm32(int rho) { const int n = rho >> 4, i = rho & 15; return 8 * (i >> 2) + 4 * n + (i & 3); }

struct Unit { int pm, pn; };
struct Gemm { const bf16_t* A; const bf16_t* Bt; int M, N, K; };

struct StaticOrder {
    int nM, nN, nwg, G, c;
    __host__ __device__ void init(int M, int N, int G_, int c_) { nM = M / BM; nN = N / BM; nwg = nM * nN; G = G_; c = c_; }
    __host__ __device__ bool next(int i, Unit& u) const {
        const long L = (long)i * G + c; if (L >= nwg) return false;
        int wgid = (int)L; { const int q = nwg / NXCD, r = nwg % NXCD, xcd = wgid % NXCD, off = wgid / NXCD; wgid = (xcd < r ? xcd * (q + 1) : r * (q + 1) + (xcd - r) * q) + off; }
        const int nig = WGM * nN, gid = wgid / nig, fm = gid * WGM, gsz = (nM - fm) < WGM ? (nM - fm) : WGM;
        u.pm = fm + ((wgid % nig) % gsz); u.pn = (wgid % nig) / gsz; return true;
    }
    __device__ __forceinline__ void a_ready(const Unit&) const {}
    __device__ __forceinline__ void done(const Unit&) const {}
};

typedef __bf16 bf16x2_hw __attribute__((ext_vector_type(2)));
typedef float f32x2_hw __attribute__((ext_vector_type(2)));
__device__ __forceinline__ unsigned cvt_pk_bf16(float lo, float hi) { f32x2_hw v = {lo, hi}; bf16x2_hw b = __builtin_convertvector(v, bf16x2_hw); return __builtin_bit_cast(unsigned, b); }

struct EpiBf16 {
    static constexpr bool PERM = true, AFTER_DRAIN = false;
    bf16_t* O; int ldc; int dsh; int split;
    __device__ __forceinline__ void operator()(const f32x4 (&acc)[2][2][4][2], const Unit& u, int wr, int wc, int fr, int fq) const {
        const int row0 = u.pm * BM + wr * 64 + fr; const int col0 = u.pn * BM + wc * 32 + 8 * fq;
        const int lsh = (u.pm * BM < split) ? 11 : 13, lmask = (1 << lsh) - 1;
#pragma unroll
        for (int ai = 0; ai < 2; ++ai)
#pragma unroll
            for (int m = 0; m < 4; ++m) { const int row = row0 + ai * HALF + m * 16, rs = row - split, pos = rs & lmask;
                const int orow = dsh ? (row - pos) + ((pos & ((1 << dsh) - 1)) << (lsh - dsh)) + (pos >> dsh) : row;
                bf16_t* rowp = O + (size_t)orow * ldc + col0;
#pragma unroll
                for (int bj = 0; bj < 2; ++bj) { const f32x4 v0 = acc[ai][bj][m][0], v1 = acc[ai][bj][m][1];
                    u32x4 w; w.x = cvt_pk_bf16(v0[0], v0[1]); w.y = cvt_pk_bf16(v0[2], v0[3]); w.z = cvt_pk_bf16(v1[0], v1[1]); w.w = cvt_pk_bf16(v1[2], v1[3]);
                    *(u32x4*)(rowp + bj * HALF) = w; } }
    }
};
struct EpiSwiglu {
    static constexpr bool PERM = true, AFTER_DRAIN = false;
    bf16_t* O; int ldc;
    __device__ __forceinline__ static float act(float g, float up) { return g * up * __builtin_amdgcn_rcpf(1.0f + __builtin_amdgcn_exp2f(-1.44269504089f * g)); }
    __device__ __forceinline__ void operator()(const f32x4 (&acc)[2][2][4][2], const Unit& u, int wr, int wc, int fr, int fq) const {
        const int row0 = u.pm * BM + wr * 64 + fr; const int col0 = u.pn * HALF + wc * 32 + 8 * fq;
#pragma unroll
        for (int ai = 0; ai < 2; ++ai)
#pragma unroll
            for (int m = 0; m < 4; ++m) { bf16_t* rowp = O + (size_t)(row0 + ai * HALF + m * 16) * ldc + col0;
                const f32x4 g0 = acc[ai][0][m][0], g1 = acc[ai][0][m][1], u0 = acc[ai][1][m][0], u1 = acc[ai][1][m][1];
                u32x4 w; w.x = cvt_pk_bf16(act(g0[0], u0[0]), act(g0[1], u0[1])); w.y = cvt_pk_bf16(act(g0[2], u0[2]), act(g0[3], u0[3]));
                w.z = cvt_pk_bf16(act(g1[0], u1[0]), act(g1[1], u1[1])); w.w = cvt_pk_bf16(act(g1[2], u1[2]), act(g1[3], u1[3]));
                *(u32x4*)rowp = w; }
    }
};
struct EpiResid {
    static constexpr bool PERM = true, AFTER_DRAIN = false;
    const float* base0; const float* base1; int split; float* out; int ldc;
    __device__ __forceinline__ void operator()(const f32x4 (&acc)[2][2][4][2], const Unit& u, int wr, int wc, int fr, int fq) const {
        const int row0 = u.pm * BM + wr * 64 + fr; const int col0 = u.pn * BM + wc * 32 + 8 * fq;
        const float* bb = (u.pm * BM < split) ? base0 : base1 - (size_t)split * ldc;
#pragma unroll
        for (int ai = 0; ai < 2; ++ai)
#pragma unroll
            for (int m = 0; m < 4; ++m) { const size_t off = (size_t)(row0 + ai * HALF + m * 16) * ldc + col0;
#pragma unroll
                for (int bj = 0; bj < 2; ++bj) {
                    const f32x4 b0 = *(const f32x4*)(bb + off + bj * HALF), b1 = *(const f32x4*)(bb + off + bj * HALF + 4);
                    *(f32x4*)(out + off + bj * HALF) = b0 + acc[ai][bj][m][0]; *(f32x4*)(out + off + bj * HALF + 4) = b1 + acc[ai][bj][m][1]; } }
    }
};


template <class Epi, class Sched, bool ALIGN_EPI = false, bool SP2 = false>
__device__ __forceinline__ void gemm_phase(PG8_LAS unsigned char* lds, const Gemm g, const Sched& S, const Epi& E, const int tid) {
    const int wid = __builtin_amdgcn_readfirstlane(tid >> 6), lane = tid & 63, wr = wid >> 2, wc = wid & 3, fr = lane & 15, fq = lane >> 4;
    const int K = g.K, nt = K / BK;
    unsigned voffA[2], voffB[2];
#pragma unroll
    for (int i = 0; i < 2; ++i) { int R, C; stage_rc(tid * 16 + i * 8192, R, C); const int Rb = Epi::PERM ? ((R & ~31) + perm32(R & 31)) : R;
        voffA[i] = (unsigned)(R * K + C) * 2u; voffB[i] = (unsigned)(Rb * K + C) * 2u; }
    const size_t kstep = (size_t)(BK * 2);
    const size_t hstep = (size_t)HALF * K * 2;
    const size_t tstep = 2 * hstep;
    const unsigned ldsw = (unsigned)wid * 1024u;
    const int aoff = lds_byte(wr * 64 + fr, fq * 8), boff = lds_byte(wc * 32 + fr, fq * 8);
#define PG8_SA(b, h) (((b) * 2 + (h)) * HTB)
#define PG8_SB(b, h) ((4 + (b) * 2 + (h)) * HTB)
#define PG8_STAGE(bufoff, gbase, voff) do { _Pragma("unroll") for (int _i = 0; _i < 2; ++_i) \
        __builtin_amdgcn_global_load_lds((const unsigned*)((const char*)(gbase) + (voff)[_i]), (PG8_LAS unsigned*)(lds + (bufoff) + ldsw + _i * 8192), 16, 0, 0); } while (0)
#define PG8_LDA(dst, b, h) do { _Pragma("unroll") for (int m = 0; m < 4; ++m) _Pragma("unroll") for (int k = 0; k < 2; ++k) dst[m][k] = *(const PG8_LAS bf16x8*)(lds + PG8_SA(b, h) + aoff + m * 2048 + k * 1024); } while (0)
#define PG8_LDB(dst, b, h) do { _Pragma("unroll") for (int n = 0; n < 2; ++n) _Pragma("unroll") for (int k = 0; k < 2; ++k) dst[n][k] = *(const PG8_LAS bf16x8*)(lds + PG8_SB(b, h) + boff + n * 2048 + k * 1024); } while (0)
#define PG8_MMA(ai, bj, At, Bt) do { __builtin_amdgcn_s_setprio(1); _Pragma("unroll") for (int m = 0; m < 4; ++m) _Pragma("unroll") for (int n = 0; n < 2; ++n) _Pragma("unroll") for (int k = 0; k < 2; ++k) \
        acc[ai][bj][m][n] = __builtin_amdgcn_mfma_f32_16x16x32_bf16(Bt[n][k], At[m][k], acc[ai][bj][m][n], 0, 0, 0); __builtin_amdgcn_s_setprio(0); } while (0)
#define PG8_WAIT_V(n) asm volatile("s_waitcnt vmcnt(" #n ")" ::: "memory")
#define PG8_WAIT_L(n) asm volatile("s_waitcnt lgkmcnt(" #n ")" ::: "memory")
#define PG8_BAR __builtin_amdgcn_s_barrier()
#define PG8_SCHED __builtin_amdgcn_sched_barrier(0)
    Unit cur, nxt; int ui = 0;
    if (!S.next(0, cur)) return;
    f32x4 acc[2][2][4][2];
#pragma unroll
    for (int a = 0; a < 2; ++a)
#pragma unroll
        for (int b = 0; b < 2; ++b)
#pragma unroll
            for (int m = 0; m < 4; ++m)
#pragma unroll
                for (int n = 0; n < 2; ++n) acc[a][b][m][n] = (f32x4){0.f, 0.f, 0.f, 0.f};
    bf16x8 At[4][2], B0[2][2], B1[2][2];
    const char* cA = (const char*)g.A + (size_t)cur.pm * tstep; const char* cB = (const char*)g.Bt + (size_t)cur.pn * tstep;
    S.a_ready(cur);
    if constexpr (SP2) {
        PG8_STAGE(PG8_SB(0, 0), cB, voffB); PG8_STAGE(PG8_SB(0, 1), cB + hstep, voffB); PG8_STAGE(PG8_SA(0, 0), cA, voffA); PG8_STAGE(PG8_SA(0, 1), cA + hstep, voffA);
        if (wr == 1) PG8_BAR;
        PG8_WAIT_V(2); PG8_BAR;
        PG8_STAGE(PG8_SB(1, 0), cB + kstep, voffB); PG8_STAGE(PG8_SA(1, 0), cA + kstep, voffA); PG8_STAGE(PG8_SB(1, 1), cB + hstep + kstep, voffB);
        PG8_WAIT_V(6); PG8_BAR;
    } else {
        PG8_STAGE(PG8_SB(0, 0), cB, voffB); PG8_STAGE(PG8_SA(0, 0), cA, voffA); PG8_STAGE(PG8_SB(0, 1), cB + hstep, voffB); PG8_STAGE(PG8_SA(0, 1), cA + hstep, voffA);
        if (wr == 1) PG8_BAR;
        PG8_WAIT_V(4); PG8_BAR;
        PG8_STAGE(PG8_SB(1, 0), cB + kstep, voffB); PG8_STAGE(PG8_SA(1, 0), cA + kstep, voffA); PG8_STAGE(PG8_SB(1, 1), cB + hstep + kstep, voffB);
        PG8_WAIT_V(6); PG8_BAR;
    }
    for (;;) {
        const bool has_next = S.next(ui + 1, nxt);
        const char* nA = has_next ? (const char*)g.A + (size_t)nxt.pm * tstep : cA; const char* nB = has_next ? (const char*)g.Bt + (size_t)nxt.pn * tstep : cB;
        for (int t = 0; t < nt; t += 2) {
            const bool last = (t == nt - 2);
            const char* a1 = cA + (size_t)(t + 1) * kstep;
            const char* a2 = last ? nA : cA + (size_t)(t + 2) * kstep; const char* b2 = last ? nB : cB + (size_t)(t + 2) * kstep;
            const char* a3 = a2 + kstep; const char* b3 = b2 + kstep;
            if (last && has_next) S.a_ready(nxt);
            if constexpr (SP2) {
            PG8_LDB(B0, 0, 0); PG8_LDB(B1, 0, 1); PG8_SCHED; PG8_LDA(At, 0, 0); PG8_STAGE(PG8_SA(1, 1), a1 + hstep, voffA);
            PG8_WAIT_V(8); PG8_WAIT_L(0); PG8_BAR; PG8_MMA(0, 0, At, B0); PG8_MMA(0, 1, At, B1); PG8_BAR; PG8_SCHED;
            PG8_LDA(At, 0, 1); PG8_STAGE(PG8_SB(0, 0), b2, voffB); PG8_STAGE(PG8_SB(0, 1), b2 + hstep, voffB); PG8_STAGE(PG8_SA(0, 0), a2, voffA);
            PG8_WAIT_V(8); PG8_WAIT_L(0); PG8_BAR; PG8_MMA(1, 0, At, B0); PG8_MMA(1, 1, At, B1); PG8_BAR; PG8_SCHED;
            PG8_LDB(B0, 1, 0); PG8_LDB(B1, 1, 1); PG8_SCHED; PG8_LDA(At, 1, 0); PG8_STAGE(PG8_SA(0, 1), a2 + hstep, voffA);
            PG8_WAIT_V(8); PG8_WAIT_L(0); PG8_BAR; PG8_MMA(0, 0, At, B0); PG8_MMA(0, 1, At, B1); PG8_BAR; PG8_SCHED;
            PG8_LDA(At, 1, 1); PG8_STAGE(PG8_SB(1, 0), b3, voffB); PG8_STAGE(PG8_SB(1, 1), b3 + hstep, voffB); PG8_STAGE(PG8_SA(1, 0), a3, voffA);
            PG8_WAIT_V(8); PG8_WAIT_L(0); PG8_BAR; PG8_MMA(1, 0, At, B0); PG8_MMA(1, 1, At, B1); PG8_BAR; PG8_SCHED;
            } else {
            PG8_LDB(B0, 0, 0); PG8_SCHED; PG8_LDA(At, 0, 0); PG8_STAGE(PG8_SA(1, 1), a1 + hstep, voffA);
            PG8_WAIT_L(8); PG8_BAR; PG8_WAIT_L(0); PG8_MMA(0, 0, At, B0); PG8_BAR; PG8_SCHED;
            PG8_LDB(B1, 0, 1); PG8_STAGE(PG8_SB(0, 0), b2, voffB);
            PG8_BAR; PG8_WAIT_L(0); PG8_MMA(0, 1, At, B1); PG8_BAR;
            PG8_LDA(At, 0, 1); PG8_STAGE(PG8_SA(0, 0), a2, voffA);
            PG8_BAR; PG8_WAIT_L(0); PG8_MMA(1, 0, At, B0); PG8_BAR; PG8_SCHED;
            PG8_STAGE(PG8_SB(0, 1), b2 + hstep, voffB);
            PG8_WAIT_V(6); PG8_BAR; PG8_MMA(1, 1, At, B1); PG8_BAR;
            PG8_LDB(B0, 1, 0); PG8_SCHED; PG8_LDA(At, 1, 0); PG8_STAGE(PG8_SA(0, 1), a2 + hstep, voffA);
            PG8_WAIT_L(8); PG8_BAR; PG8_WAIT_L(0); PG8_MMA(0, 0, At, B0); PG8_BAR; PG8_SCHED;
            PG8_LDB(B1, 1, 1); PG8_STAGE(PG8_SB(1, 0), b3, voffB);
            PG8_BAR; PG8_WAIT_L(0); PG8_MMA(0, 1, At, B1); PG8_BAR;
            PG8_LDA(At, 1, 1); PG8_STAGE(PG8_SA(1, 0), a3, voffA);
            PG8_BAR; PG8_WAIT_L(0); PG8_MMA(1, 0, At, B0); PG8_BAR; PG8_SCHED;
            PG8_STAGE(PG8_SB(1, 1), b3 + hstep, voffB);
            PG8_WAIT_V(6); PG8_BAR; PG8_MMA(1, 1, At, B1); PG8_BAR;
            }
        }
        if constexpr (ALIGN_EPI) { if (wr == 0) PG8_BAR; }
        if constexpr (!Epi::AFTER_DRAIN) { E(acc, cur, wr, wc, fr, fq); S.done(cur); }
        if (!has_next) break;
#pragma unroll
        for (int a = 0; a < 2; ++a)
#pragma unroll
            for (int b = 0; b < 2; ++b)
#pragma unroll
                for (int m = 0; m < 4; ++m)
#pragma unroll
                    for (int n = 0; n < 2; ++n) acc[a][b][m][n] = (f32x4){0.f, 0.f, 0.f, 0.f};
        cur = nxt; cA = nA; cB = nB; ++ui;
        if constexpr (ALIGN_EPI) { if (wr == 1) PG8_BAR; }
    }
    PG8_WAIT_V(0);
    if constexpr (!ALIGN_EPI) { if (wr == 0) PG8_BAR; }
    PG8_BAR;
    if constexpr (Epi::AFTER_DRAIN) { E.fused(acc, cur, wr, wc, fr, fq, lds, wid, lane); S.done(cur); }
#undef PG8_SA
#undef PG8_SB
#undef PG8_STAGE
#undef PG8_LDA
#undef PG8_LDB
#undef PG8_MMA
#undef PG8_WAIT_V
#undef PG8_WAIT_L
#undef PG8_BAR
#undef PG8_SCHED
}
}

constexpr int NWAVES = 8;
constexpr int D = 1024, DFF = 2816, NQKV = 1536;
constexpr int ROWS_P = 16 * 2048, ROWS_S = 8 * 8192, M = ROWS_P + ROWS_S;
constexpr float EPS = 1e-6f, LOG2E = 1.44269504089f;
#ifndef MK_SINGLE
#define MK_SINGLE 1
#endif
constexpr int NPHASES = 18;
#ifndef PROBE_DIAG
#define PROBE_DIAG 0
#endif
#ifndef REPEAT_N
#define REPEAT_N 4
#endif
#ifndef REPEAT_MASK
#define REPEAT_MASK 0
#endif

constexpr size_t MiB = 1u << 20;
constexpr size_t WS_WQKVA = 2 * MiB;
constexpr size_t WS_WOA   = 5 * MiB;
constexpr size_t WS_WQKVB = 7 * MiB;
constexpr size_t WS_WOB   = 16 * MiB;
constexpr size_t WS_WGU   = 18 * MiB;
constexpr size_t WS_WDN   = 40 * MiB;
constexpr size_t WS_H     = 64 * MiB;
constexpr size_t WS_QKV   = 256 * MiB;
constexpr size_t WS_O0    = 544 * MiB;
constexpr size_t WS_O1    = 736 * MiB;
constexpr size_t WS_LSE   = 928 * MiB;
constexpr size_t WS_ACT   = 256 * MiB;
constexpr size_t WS_END   = 944 * MiB;
static_assert(WS_ACT + (size_t)M * DFF * 2 <= WS_LSE && WS_LSE + (size_t)2 * M * 16 * 4 <= WS_END, "ws map");

constexpr int LDS_BYTES = 147456;

#define LAS __attribute__((address_space(3)))
typedef unsigned short bf16;
typedef float f32x4 __attribute__((ext_vector_type(4)));
typedef float f32x16 __attribute__((ext_vector_type(16)));
typedef short bf16x8 __attribute__((ext_vector_type(8)));
typedef short s16x4 __attribute__((ext_vector_type(4)));
typedef unsigned u32x4 __attribute__((ext_vector_type(4)));
typedef unsigned u32x2 __attribute__((ext_vector_type(2)));
using pg8::cvt_pk_bf16;
__device__ __forceinline__ float bf2f(short s) { return __builtin_bit_cast(float, (unsigned)(unsigned short)s << 16); }
__device__ __forceinline__ float wave_sum(float v) {
#pragma unroll
    for (int o = 1; o < 64; o <<= 1) v += __shfl_xor(v, o);
    return v;
}

struct Args { const float* in[16]; float* out; unsigned char* ws; int ph_lo, ph_hi; };

__device__ __forceinline__ void transpose_item(const float* W, int K, int N, bf16* WT, int k0, int n0, int drow0, LAS float* scr, int lane) {
#pragma unroll 8
    for (int i = 0; i < 32; ++i) { const int kk = 2 * i + (lane >> 5); scr[kk * 33 + (lane & 31)] = W[(size_t)(k0 + kk) * N + n0 + (lane & 31)]; }
    asm volatile("s_waitcnt lgkmcnt(0)" ::: "memory");
    const int c = lane & 7;
#pragma unroll
    for (int j = 0; j < 4; ++j) { const int n = (lane >> 3) + 8 * j; const LAS float* s = scr + (8 * c) * 33 + n;
        u32x4 o; o.x = cvt_pk_bf16(s[0 * 33], s[1 * 33]); o.y = cvt_pk_bf16(s[2 * 33], s[3 * 33]); o.z = cvt_pk_bf16(s[4 * 33], s[5 * 33]); o.w = cvt_pk_bf16(s[6 * 33], s[7 * 33]);
        *(u32x4*)(WT + (size_t)(drow0 + n) * K + k0 + 8 * c) = o; }
    asm volatile("s_waitcnt lgkmcnt(0)" ::: "memory");
}
__device__ __forceinline__ void prologue_weights(const Args& a, LAS unsigned char* lds, int gw, int NGW, int wave, int lane) {
    LAS float* scr = (LAS float*)(lds + wave * 16384);
    unsigned char* ws = a.ws;
    constexpr int I_QA = 16 * 48, I_O = 16 * 32, I_QB = 16 * 144, I_GU = 16 * 176, I_DN = 44 * 32;
    constexpr int NITEMS = I_QA + I_O + I_QB + I_O + 2 * I_GU + 2 * I_DN;
    for (int it = gw; it < NITEMS; it += NGW) {
        int r = it;
        if (r < I_QA) { transpose_item(a.in[5], D, NQKV, (bf16*)(ws + WS_WQKVA), 64 * (r / 48), 32 * (r % 48), 32 * (r % 48), scr, lane); continue; } r -= I_QA;
        if (r < I_O)  { transpose_item(a.in[9], D, D, (bf16*)(ws + WS_WOA), 64 * (r / 32), 32 * (r % 32), 32 * (r % 32), scr, lane); continue; } r -= I_O;
        if (r < I_QB) { transpose_item(a.in[10], D, 3 * NQKV, (bf16*)(ws + WS_WQKVB), 64 * (r / 144), 32 * (r % 144), 32 * (r % 144), scr, lane); continue; } r -= I_QB;
        if (r < I_O)  { transpose_item(a.in[13], D, D, (bf16*)(ws + WS_WOB), 64 * (r / 32), 32 * (r % 32), 32 * (r % 32), scr, lane); continue; } r -= I_O;
        if (r < 2 * I_GU) { const int l = r / I_GU; r -= l * I_GU; const int n0 = 32 * (r % 176); const int f = n0 < DFF ? n0 : n0 - DFF;
            const int drow = 256 * (f / 128) + (n0 < DFF ? 0 : 128) + (f % 128);
            transpose_item(a.in[14] + (size_t)l * D * 2 * DFF, D, 2 * DFF, (bf16*)(ws + WS_WGU) + (size_t)l * 2 * DFF * D, 64 * (r / 176), n0, drow, scr, lane); continue; } r -= 2 * I_GU;
        { const int l = r / I_DN; r -= l * I_DN;
            transpose_item(a.in[15] + (size_t)l * DFF * D, DFF, D, (bf16*)(ws + WS_WDN) + (size_t)l * D * DFF, 64 * (r / 32), 32 * (r % 32), 32 * (r % 32), scr, lane); }
    }
}
__device__ __forceinline__ void norm_phase(const float* x0, const float* x1, const float* g, bf16* H, int gw, int NGW, int lane) {
    f32x4 gv[4];
#pragma unroll
    for (int j = 0; j < 4; ++j) gv[j] = *(const f32x4*)(g + 4 * lane + 256 * j);
    for (int m = gw; m < M; m += NGW) {
        const float* xr = (m < ROWS_P) ? x0 + (size_t)m * D : x1 + (size_t)(m - ROWS_P) * D;
        f32x4 v[4]; float s = 0.f;
#pragma unroll
        for (int j = 0; j < 4; ++j) { v[j] = *(const f32x4*)(xr + 4 * lane + 256 * j); s += (v[j].x * v[j].x + v[j].y * v[j].y) + (v[j].z * v[j].z + v[j].w * v[j].w); }
        const float rstd = 1.0f / sqrtf(wave_sum(s) * (1.0f / D) + EPS);
        bf16* orow = H + (size_t)m * D + 4 * lane;
#pragma unroll
        for (int j = 0; j < 4; ++j) { const f32x4 t = v[j] * rstd * gv[j]; u32x2 o; o.x = cvt_pk_bf16(t.x, t.y); o.y = cvt_pk_bf16(t.z, t.w); *(u32x2*)(orow + 256 * j) = o; }
    }
}

__device__ __forceinline__ float xhalf_max(float m) { auto rr = __builtin_amdgcn_permlane32_swap(__builtin_bit_cast(unsigned, m), __builtin_bit_cast(unsigned, m), false, false); return fmaxf(__builtin_bit_cast(float, rr[0]), __builtin_bit_cast(float, rr[1])); }
__device__ __forceinline__ float xhalf_sum(float m) { auto rr = __builtin_amdgcn_permlane32_swap(__builtin_bit_cast(unsigned, m), __builtin_bit_cast(unsigned, m), false, false); return __builtin_bit_cast(float, rr[0]) + __builtin_bit_cast(float, rr[1]); }
struct AttU { int kvh, rowp, rown, Ls, t0; };
__device__ __forceinline__ AttU att_decode(int kvh, int tile, int dsh) {
    AttU a; a.kvh = kvh; int seq_row0, lsh, tin;
    if (tile < 512) { seq_row0 = (tile >> 5) * 2048; lsh = 11; tin = tile & 31; }
    else { const int t2 = tile - 512; seq_row0 = ROWS_P + (t2 >> 7) * 8192; lsh = 13; tin = t2 & 127; }
    const int tsh = lsh - dsh - 6, r = tin >> tsh; a.Ls = 1 << (lsh - dsh); a.rown = seq_row0 + r; a.rowp = seq_row0 + r * a.Ls; a.t0 = (tin & ((1 << tsh) - 1)) * 64; return a;
}
__device__ __forceinline__ bool att_unit(int i, int G, int bid, int& kvh, int& tile) {
    constexpr int NT = 16 * 32 + 8 * 128;
    if (G == 256) { const int xcd = bid & 7; kvh = xcd & 3; tile = (2 * i + (xcd >> 2)) * 32 + (bid >> 3); return tile < NT; }
    const int u = bid + i * G; kvh = u & 3; tile = u >> 2; return tile < NT;
}
template <int HW, int MODE, int DIAG = 0>
__device__ __forceinline__ void attn_phase(LAS unsigned char* lds, const bf16* __restrict__ QKV, bf16* O, const bf16* P1, float* LSEw, const float* LSE0, const float* LSE1,
                                           int dsh, const float* gq, const float* gk, const float* sink, const float* rel_table, int G, int bid, const int tid) {
    constexpr int NK = 64 + 2 * HW, KST = 144, VST = NK * 2 + 8, TBN = 2 * HW + 64, NPASS = NK / 64;
    constexpr int NVIT = NK * 2, NVI = (NVIT + 511) / 512;
    constexpr int KS_OFF = 0, VT_OFF = NK * KST, TB_OFF = VT_OFF + 64 * VST, GQ_OFF = TB_OFF + 16 * TBN * 4;
    static_assert(GQ_OFF + 256 + 16 <= 131072, "attention LDS");
    const int lane = tid & 63, w = __builtin_amdgcn_readfirstlane(tid >> 6), hh = w >> 1, half = w & 1;
    const int ql = lane & 31, g2 = lane >> 5;
    const int skk = tid >> 3, sdc = tid & 7;
    float gkr[8];
#pragma unroll
    for (int i = 0; i < 8; ++i) gkr[i] = gk[sdc * 8 + i];
    LAS float* Tb = (LAS float*)(lds + TB_OFF);
    LAS float* Gq = (LAS float*)(lds + GQ_OFF);
    LAS float* Sh = (LAS float*)(lds + GQ_OFF + 256);
    if (tid < 64) Gq[tid] = gq[tid] * (0.125f * LOG2E);
    int tb_kvh = -1;
    bf16x8 kraw[NPASS], vraw[NVI][4], qr[4];
#define ATT_LOADS(au) do { \
        const bf16* base_ = QKV + (size_t)(au).rowp * NQKV; \
          \
        _Pragma("unroll") for (int p = 0; p < NPASS; ++p) { int t = (au).t0 - HW + p * 64 + skk; t = t < 0 ? 0 : (t >= (au).Ls ? (au).Ls - 1 : t); \
            kraw[p] = *(const bf16x8*)(base_ + (size_t)t * NQKV + D + (au).kvh * 64 + sdc * 8); } \
        _Pragma("unroll") for (int iv = 0; iv < NVI; ++iv) { const int it = tid + 512 * iv, kg = (it < NVIT ? it : tid) >> 3; \
            _Pragma("unroll") for (int jj = 0; jj < 4; ++jj) { int t = (au).t0 - HW + 4 * kg + jj; t = t < 0 ? 0 : (t >= (au).Ls ? (au).Ls - 1 : t); \
                vraw[iv][jj] = *(const bf16x8*)(base_ + (size_t)t * NQKV + D + 256 + (au).kvh * 64 + sdc * 8); } } \
        { const bf16* qp_ = base_ + (size_t)((au).t0 + 32 * half + ql) * NQKV + ((au).kvh * 4 + hh) * 64 + 8 * g2; \
            _Pragma("unroll") for (int ks = 0; ks < 4; ++ks) qr[ks] = *(const bf16x8*)(qp_ + 16 * ks); } \
    } while (0)
    int ui = 0, ukvh, utile;
    bool have = att_unit(0, G, bid, ukvh, utile);
    AttU cu = att_decode(have ? ukvh : 0, have ? utile : 0, dsh);
    ATT_LOADS(cu);
    for (; have; ++ui) {
        const int kvh = cu.kvh, t0 = cu.t0, Ls = cu.Ls;
        const int h = kvh * 4 + hh;
        const int rowq = cu.rown + ((t0 + 32 * half + ql) << dsh);
        if (kvh != tb_kvh) {
            float gqm = 0.f, gkm = 0.f;
            for (int i = 0; i < 64; ++i) { gqm = fmaxf(gqm, fabsf(gq[i])); gkm = fmaxf(gkm, fabsf(gk[i])); }
            float sh[4];
#pragma unroll
            for (int hq = 0; hq < 4; ++hq) { float bm = -1e30f; for (int b = 0; b < 32; ++b) bm = fmaxf(bm, rel_table[b * 16 + kvh * 4 + hq]); sh[hq] = (8.0f * gqm * gkm + bm) * LOG2E; }
            if (tid < 4) Sh[tid] = tid == 0 ? sh[0] : tid == 1 ? sh[1] : tid == 2 ? sh[2] : sh[3];
            for (int e = tid; e < 16 * TBN; e += NWAVES * 64) {
                const int hq = e / (4 * TBN), b4 = (e / TBN) & 3, j = e % TBN, idx = j + 3 - b4, rel = idx - 31 - HW; float v = -1e30f;
                if (rel >= -HW && rel <= HW) { const int off = rel * (1 << dsh), n = off < 0 ? -off : off;
                    int b = n < 8 ? n : (n < 15 ? 8 : n < 27 ? 9 : n < 50 ? 10 : n < 91 ? 11 : n < 166 ? 12 : n < 305 ? 13 : n < 559 ? 14 : 15);
                    b += off > 0 ? 16 : 0; v = rel_table[b * 16 + kvh * 4 + hq] * LOG2E - (hq == 0 ? sh[0] : hq == 1 ? sh[1] : hq == 2 ? sh[2] : sh[3]); }
                Tb[e] = v; }
            tb_kvh = kvh;
        }
        if (DIAG >= 3) { _Pragma("unroll") for (int p = 0; p < NPASS; ++p) asm volatile("" :: "v"(kraw[p])); _Pragma("unroll") for (int iv = 0; iv < NVI; ++iv) _Pragma("unroll") for (int jj = 0; jj < 4; ++jj) asm volatile("" :: "v"(vraw[iv][jj])); }
        if (DIAG < 3)
#pragma unroll
        for (int p = 0; p < NPASS; ++p) {
            const int kk = p * 64 + skk; float f[8]; float ss = 0.f;
#pragma unroll
            for (int j = 0; j < 8; ++j) { f[j] = bf2f(kraw[p][j]); ss += f[j] * f[j]; }
            ss += __shfl_xor(ss, 1); ss += __shfl_xor(ss, 2); ss += __shfl_xor(ss, 4);
            const float rs = 1.0f / sqrtf(ss * (1.0f / 64.0f) + EPS);
            u32x4 pk; pk.x = cvt_pk_bf16(f[0] * rs * gkr[0], f[1] * rs * gkr[1]); pk.y = cvt_pk_bf16(f[2] * rs * gkr[2], f[3] * rs * gkr[3]);
            pk.z = cvt_pk_bf16(f[4] * rs * gkr[4], f[5] * rs * gkr[5]); pk.w = cvt_pk_bf16(f[6] * rs * gkr[6], f[7] * rs * gkr[7]);
            *(LAS u32x4*)(lds + KS_OFF + kk * KST + sdc * 16) = pk;
        }
        if (DIAG < 3)
#pragma unroll
        for (int iv = 0; iv < NVI; ++iv) { const int it = tid + 512 * iv, kg = it >> 3;
            if (it < NVIT) {
#pragma unroll
                for (int j = 0; j < 8; ++j) { const s16x4 t4 = {vraw[iv][0][j], vraw[iv][1][j], vraw[iv][2][j], vraw[iv][3][j]};
                    *(LAS s16x4*)(lds + VT_OFF + (sdc * 8 + j) * VST + kg * 8) = t4; } } }
        __syncthreads();
        bf16x8 qf[4];
        {
            float ss = 0.f;
#pragma unroll
            for (int ks = 0; ks < 4; ++ks)
#pragma unroll
                for (int j = 0; j < 8; ++j) { const float f = bf2f(qr[ks][j]); ss += f * f; }
            ss += __shfl_xor(ss, 32);
            const float rs = 1.0f / sqrtf(ss * (1.0f / 64.0f) + EPS);
#pragma unroll
            for (int ks = 0; ks < 4; ++ks) { const f32x4 ga = *(const LAS f32x4*)(Gq + 16 * ks + 8 * g2), gb = *(const LAS f32x4*)(Gq + 16 * ks + 8 * g2 + 4); u32x4 pk;
                pk.x = cvt_pk_bf16(bf2f(qr[ks][0]) * rs * ga[0], bf2f(qr[ks][1]) * rs * ga[1]); pk.y = cvt_pk_bf16(bf2f(qr[ks][2]) * rs * ga[2], bf2f(qr[ks][3]) * rs * ga[3]);
                pk.z = cvt_pk_bf16(bf2f(qr[ks][4]) * rs * gb[0], bf2f(qr[ks][5]) * rs * gb[1]); pk.w = cvt_pk_bf16(bf2f(qr[ks][6]) * rs * gb[2], bf2f(qr[ks][7]) * rs * gb[3]);
                qf[ks] = __builtin_bit_cast(bf16x8, pk); }
        }
        { int nk, nt; have = att_unit(ui + 1, G, bid, nk, nt); if (have) cu = att_decode(nk, nt, dsh); ATT_LOADS(cu); }
        f32x16 o0, o1;
#pragma unroll
        for (int i = 0; i < 16; ++i) { o0[i] = 0.f; o1[i] = 0.f; }
        float lsum = 0.f; const float mrun = Sh[hh];
        int c_lo = half, c_hi = half + HW / 16;
        { const int lo2 = (HW - t0 + 31) >> 5, hi2 = ((Ls + HW - t0) >> 5) - 1; c_lo = lo2 > c_lo ? lo2 : c_lo; c_hi = hi2 < c_hi ? hi2 : c_hi; }
        if (DIAG >= 2) c_hi = c_lo - 1;
        const LAS unsigned char* kbase = lds + KS_OFF + ql * KST + 16 * g2;
        const LAS float* tbase = Tb + (hh * 4 + (ql & 3)) * TBN + 28 - (ql & ~3) + 4 * g2 - 32 * half;
        const LAS unsigned char* vbase = lds + VT_OFF + ql * VST + 8 * g2;
        bf16x8 ka[4];
#pragma unroll
        for (int ks = 0; ks < 4; ++ks) ka[ks] = *(const LAS bf16x8*)(kbase + c_lo * 32 * KST + 32 * ks);
        for (int c = c_lo; c <= c_hi; ++c) {
            f32x4 bz[4]; s16x4 vf[2][4]; bf16x8 kn[4];
#pragma unroll
            for (int q4 = 0; q4 < 4; ++q4) bz[q4] = *(const LAS f32x4*)(tbase + 32 * c + 8 * q4);
            const int cn = c < c_hi ? c + 1 : c;
#pragma unroll
            for (int ks = 0; ks < 4; ++ks) kn[ks] = *(const LAS bf16x8*)(kbase + cn * 32 * KST + 32 * ks);
#pragma unroll
            for (int mt = 0; mt < 2; ++mt)
#pragma unroll
                for (int j = 0; j < 4; ++j) vf[mt][j] = *(const LAS s16x4*)(vbase + mt * 32 * VST + c * 64 + 16 * j);
            __builtin_amdgcn_sched_barrier(0);
            f32x16 s;
#pragma unroll
            for (int i = 0; i < 16; ++i) s[i] = 0.f;
#pragma unroll
            for (int ks = 0; ks < 4; ++ks) s = __builtin_amdgcn_mfma_f32_32x32x16_bf16(ka[ks], qf[ks], s, 0, 0, 0);
#pragma unroll
            for (int i = 0; i < 16; ++i) { s[i] = __builtin_amdgcn_exp2f(s[i] + bz[i >> 2][i & 3]); lsum += s[i]; }
            u32x4 pa, pb;
            pa.x = cvt_pk_bf16(s[0], s[1]); pa.y = cvt_pk_bf16(s[2], s[3]); pa.z = cvt_pk_bf16(s[4], s[5]); pa.w = cvt_pk_bf16(s[6], s[7]);
            pb.x = cvt_pk_bf16(s[8], s[9]); pb.y = cvt_pk_bf16(s[10], s[11]); pb.z = cvt_pk_bf16(s[12], s[13]); pb.w = cvt_pk_bf16(s[14], s[15]);
            const bf16x8 p0 = __builtin_bit_cast(bf16x8, pa), p1 = __builtin_bit_cast(bf16x8, pb);
            o0 = __builtin_amdgcn_mfma_f32_32x32x16_bf16(__builtin_shufflevector(vf[0][0], vf[0][1], 0, 1, 2, 3, 4, 5, 6, 7), p0, o0, 0, 0, 0);
            o1 = __builtin_amdgcn_mfma_f32_32x32x16_bf16(__builtin_shufflevector(vf[1][0], vf[1][1], 0, 1, 2, 3, 4, 5, 6, 7), p0, o1, 0, 0, 0);
            o0 = __builtin_amdgcn_mfma_f32_32x32x16_bf16(__builtin_shufflevector(vf[0][2], vf[0][3], 0, 1, 2, 3, 4, 5, 6, 7), p1, o0, 0, 0, 0);
            o1 = __builtin_amdgcn_mfma_f32_32x32x16_bf16(__builtin_shufflevector(vf[1][2], vf[1][3], 0, 1, 2, 3, 4, 5, 6, 7), p1, o1, 0, 0, 0);
#pragma unroll
            for (int ks = 0; ks < 4; ++ks) ka[ks] = kn[ks];
        }
        lsum += __shfl_xor(lsum, 32);
        if (MODE == 0) lsum += __builtin_amdgcn_exp2f(sink[h] * LOG2E - mrun);
        float f0 = 0.f, f1 = 0.f, f2 = 1.0f / lsum;
        if (MODE == 1 && DIAG == 0) { if (g2 == 0) LSEw[(size_t)rowq * 16 + h] = mrun + __builtin_amdgcn_logf(lsum); }
        if (MODE == 2) {
            const float l2 = mrun + __builtin_amdgcn_logf(lsum), l0 = LSE0[(size_t)rowq * 16 + h], l1 = LSE1[(size_t)rowq * 16 + h];
            const float mm = fmaxf(l2, fmaxf(l0, l1)), w0 = __builtin_amdgcn_exp2f(l0 - mm), w1 = __builtin_amdgcn_exp2f(l1 - mm), w2 = __builtin_amdgcn_exp2f(l2 - mm);
            const float iw = 1.0f / (w0 + w1 + w2); f0 = w0 * iw; f1 = w1 * iw; f2 = w2 * iw / lsum;
        }
        bf16* op = O + (size_t)rowq * D + h * 64 + 4 * g2;
        const bf16* pp = P1 + (size_t)rowq * D + h * 64 + 4 * g2;
#pragma unroll
        for (int mt = 0; mt < 2; ++mt)
#pragma unroll
            for (int q4 = 0; q4 < 4; ++q4) {
                float v[4];
#pragma unroll
                for (int j = 0; j < 4; ++j) v[j] = (mt == 0 ? o0[4 * q4 + j] : o1[4 * q4 + j]) * f2;
                if (MODE == 2) { const s16x4 a = *(const s16x4*)(op + mt * 32 + 8 * q4), b = *(const s16x4*)(pp + mt * 32 + 8 * q4);
#pragma unroll
                    for (int j = 0; j < 4; ++j) v[j] += f0 * bf2f(a[j]) + f1 * bf2f(b[j]); }
                u32x2 o; o.x = cvt_pk_bf16(v[0], v[1]); o.y = cvt_pk_bf16(v[2], v[3]);
                if (DIAG == 0) *(u32x2*)(op + mt * 32 + 8 * q4) = o; else asm volatile("" :: "v"(o));
            }
        __syncthreads();
    }
#undef ATT_LOADS
}


__global__ void __launch_bounds__(NWAVES * 64, 2) fwd_megakernel(Args a) {
    extern __shared__ __attribute__((aligned(16))) unsigned char lds_raw[];
    LAS unsigned char* lds = (LAS unsigned char*)lds_raw;
    cg::grid_group grid = cg::this_grid();
    const int G = gridDim.x, bid = blockIdx.x;
    unsigned char* ws = a.ws;
    bf16* H = (bf16*)(ws + WS_H); bf16* QKV = (bf16*)(ws + WS_QKV); bf16* O0 = (bf16*)(ws + WS_O0); bf16* O1 = (bf16*)(ws + WS_O1); bf16* ACT = (bf16*)(ws + WS_ACT);
    float* LSE0 = (float*)(ws + WS_LSE); float* LSE1 = LSE0 + (size_t)M * 16;
    const float* xin0 = a.in[0]; const float* xin1 = a.in[1]; float* out = a.out;

    for (int ph = a.ph_lo, rep = 0; ph < a.ph_hi;) {
        int tid = threadIdx.x; asm volatile("" : "+v"(tid));
        const int lane = tid & 63, wave = __builtin_amdgcn_readfirstlane(tid >> 6), gw = bid * NWAVES + wave, NGW = G * NWAVES;
        if (ph == 0) { prologue_weights(a, lds, gw, NGW, wave, lane); norm_phase(xin0, xin1, a.in[3], H, gw, NGW, lane); }
        else if (ph == 4 || ph == 7 || ph == 15) {
            const float* g = ph == 4 ? a.in[4] : ph == 7 ? a.in[3] + D : a.in[4] + D;
            norm_phase(out, out + (size_t)ROWS_P * D, g, H, gw, NGW, lane);
        }
        else if (ph == 1 || ph == 8 || ph == 10 || ph == 12) {
            const bf16* Bt = ph == 1 ? (const bf16*)(ws + WS_WQKVA) : (const bf16*)(ws + WS_WQKVB) + (size_t)((ph - 8) >> 1) * NQKV * D;
            pg8::Gemm g{H, Bt, M, NQKV, D}; pg8::StaticOrder S; S.init(M, NQKV, G, bid);
            pg8::EpiBf16 E{QKV, NQKV, ph == 10 ? 2 : ph == 12 ? 4 : 0, ROWS_P};
            pg8::gemm_phase<pg8::EpiBf16, pg8::StaticOrder, true, true>(lds, g, S, E, tid);
        }
        else if (ph == 2) attn_phase<128, 0>(lds, QKV, O0, nullptr, nullptr, nullptr, nullptr, 0, a.in[6], a.in[7], a.in[8], a.in[2], G, bid, tid);
        else if (ph == 9 || ph == 11) {
            const int gi = (ph - 9) >> 1;
#if PROBE_DIAG
            if (rep >= 1) attn_phase<64, 1, PROBE_DIAG>(lds, QKV, gi ? O1 : O0, nullptr, gi ? LSE1 : LSE0, nullptr, nullptr, 2 * gi, a.in[11] + 64 * gi, a.in[12] + 64 * gi, nullptr, a.in[2], G, bid, tid); else
#endif
            attn_phase<64, 1>(lds, QKV, gi ? O1 : O0, nullptr, gi ? LSE1 : LSE0, nullptr, nullptr, 2 * gi, a.in[11] + 64 * gi, a.in[12] + 64 * gi, nullptr, a.in[2], G, bid, tid);
        }
        else if (ph == 13) attn_phase<64, 2>(lds, QKV, O0, O1, nullptr, LSE0, LSE1, 4, a.in[11] + 128, a.in[12] + 128, nullptr, a.in[2], G, bid, tid);
        else if (ph == 3 || ph == 14 || ph == 6 || ph == 17) {
            const bool isdown = (ph == 6 || ph == 17);
            const bf16* A = isdown ? ACT : O0;
            const bf16* Bt = ph == 3 ? (const bf16*)(ws + WS_WOA) : ph == 14 ? (const bf16*)(ws + WS_WOB) : (const bf16*)(ws + WS_WDN) + (size_t)(ph == 17 ? 1 : 0) * D * DFF;
            pg8::Gemm g{A, Bt, M, D, isdown ? DFF : D}; pg8::StaticOrder S; S.init(M, D, G, bid);
            pg8::EpiResid E{ph == 3 ? xin0 : out, ph == 3 ? xin1 : out + (size_t)ROWS_P * D, ROWS_P, out, D};
            pg8::gemm_phase<pg8::EpiResid, pg8::StaticOrder, true, true>(lds, g, S, E, tid);
        }
        else {
            const bf16* Bt = (const bf16*)(ws + WS_WGU) + (size_t)(ph == 16 ? 1 : 0) * 2 * DFF * D;
            pg8::Gemm g{H, Bt, M, 2 * DFF, D}; pg8::StaticOrder S; S.init(M, 2 * DFF, G, bid);
            pg8::EpiSwiglu E{ACT, DFF};
            pg8::gemm_phase<pg8::EpiSwiglu, pg8::StaticOrder, true, true>(lds, g, S, E, tid);
        }
        const bool again = ((REPEAT_MASK >> ph) & 1) && rep < REPEAT_N;
        if (ph + 1 < a.ph_hi || again) grid.sync();
        if (again) ++rep; else { rep = 0; ++ph; }
    }
}

extern "C" void kernel_launch(void* const* d_in, const int* in_sizes, int n_in, void* d_out, int out_size, void* d_ws, size_t ws_size, hipStream_t stream) {
    static int grid = 0;
    if (grid == 0) {
        if (n_in != 16 || out_size != M * D || ws_size < WS_END) { fprintf(stderr, "kernel_launch: unexpected shapes (n_in %d out %d ws %zu)\n", n_in, out_size, ws_size); grid = -1; return; }
        int dev = 0, cus = 0, per_cu = 0;
        hipGetDevice(&dev); hipDeviceGetAttribute(&cus, hipDeviceAttributeMultiprocessorCount, dev);
        if (hipFuncSetAttribute((const void*)fwd_megakernel, hipFuncAttributeMaxDynamicSharedMemorySize, LDS_BYTES) != hipSuccess) { fprintf(stderr, "kernel_launch: hipFuncSetAttribute failed\n"); grid = -1; return; }
        hipOccupancyMaxActiveBlocksPerMultiprocessor(&per_cu, (const void*)fwd_megakernel, NWAVES * 64, LDS_BYTES);
        if (per_cu < 1) { fprintf(stderr, "kernel_launch: occupancy query says %d blocks/CU\n", per_cu); per_cu = 1; }
        (void)hipGetLastError();
        grid = cus;
    }
    if (grid < 0) return;
    Args a{};
    for (int i = 0; i < 16; ++i) a.in[i] = (const float*)d_in[i];
    a.out = (float*)d_out; a.ws = (unsigned char*)d_ws;
#if MK_SINGLE
    a.ph_lo = 0; a.ph_hi = NPHASES;
    void* kargs[] = {&a};
    hipError_t e = hipLaunchCooperativeKernel((const void*)fwd_megakernel, dim3(grid), dim3(NWAVES * 64), kargs, LDS_BYTES, stream);
    if (e != hipSuccess) fprintf(stderr, "kernel_launch: cooperative launch failed: %s (grid %d)\n", hipGetErrorString(e), grid);
#else
    for (int ph = 0; ph < NPHASES; ++ph) { a.ph_lo = ph; a.ph_hi = ph + 1; hipLaunchKernelGGL(fwd_megakernel, dim3(grid), dim3(NWAVES * 64), LDS_BYTES, stream, a); }
#endif
}
```

```cpp
#include <hip/hip_runtime.h>
#include <hip/hip_cooperative_groups.h>
#include <cstdio>
#include <cstdint>
namespace cg = cooperative_groups;
namespace pg8 {
#define PG8_LAS __attribute__((address_space(3)))
typedef unsigned short bf16_t;
typedef short bf16x8 __attribute__((ext_vector_type(8)));
typedef float f32x4 __attribute__((ext_vector_type(4)));
typedef unsigned u32x4 __attribute__((ext_vector_type(4)));
constexpr int BM = 256, BK = 64, HALF = 128, HTB = HALF * BK * 2  , STAGE_BYTES = 8 * HTB, NXCD = 8, WGM = 8;

__host__ __device__ __forceinline__ int lds_byte(int r, int c) { const int st = (r >> 4) * 2 + (c >> 5), rr = r & 15, cc = c & 31, ob = rr * 64 + cc * 2; return st * 1024 + (ob ^ (((ob >> 9) & 1) << 5)); }
__host__ __device__ __forceinline__ void stage_rc(int b, int& R, int& C) { const int st = b / 1024, sb = b % 1024, swz = sb ^ (((sb >> 9) & 1) << 5); R = (st >> 1) * 16 + swz / 64; C = (st & 1) * 32 + (swz % 64) / 2; }
__host__ __device__ __forceinline__ int perm32(int rho) { const int n = rho >> 4, i = rho & 15; return 8 * (i >> 2) + 4 * n + (i & 3); }

struct Unit { int pm, pn; };
struct Gemm { const bf16_t* A; const bf16_t* Bt; int M, N, K; };

struct StaticOrder {
    int nM, nN, nwg, G, c;
    __host__ __device__ void init(int M, int N, int G_, int c_) { nM = M / BM; nN = N / BM; nwg = nM * nN; G = G_; c = c_; }
    __host__ __device__ bool next(int i, Unit& u) const {
        const long L = (long)i * G + c; if (L >= nwg) return false;
        int wgid = (int)L; { const int q = nwg / NXCD, r = nwg % NXCD, xcd = wgid % NXCD, off = wgid / NXCD; wgid = (xcd < r ? xcd * (q + 1) : r * (q + 1) + (xcd - r) * q) + off; }
        const int nig = WGM * nN, gid = wgid / nig, fm = gid * WGM, gsz = (nM - fm) < WGM ? (nM - fm) : WGM;
        u.pm = fm + ((wgid % nig) % gsz); u.pn = (wgid % nig) / gsz; return true;
    }
    __device__ __forceinline__ void a_ready(const Unit&) const {}
    __device__ __forceinline__ void done(const Unit&) const {}
};

typedef __bf16 bf16x2_hw __attribute__((ext_vector_type(2)));
typedef float f32x2_hw __attribute__((ext_vector_type(2)));
__device__ __forceinline__ unsigned cvt_pk_bf16(float lo, float hi) { f32x2_hw v = {lo, hi}; bf16x2_hw b = __builtin_convertvector(v, bf16x2_hw); return __builtin_bit_cast(unsigned, b); }

struct EpiBf16 {
    static constexpr bool PERM = true, AFTER_DRAIN = false;
    bf16_t* O; int ldc; int dsh; int split;
    const float* rss;
    __device__ __forceinline__ void operator()(const f32x4 (&acc)[2][2][4][2], const Unit& u, int wr, int wc, int fr, int fq) const {
        const int row0 = u.pm * BM + wr * 64 + fr; const int col0 = u.pn * BM + wc * 32 + 8 * fq;
        const int lsh = (u.pm * BM < split) ? 11 : 13, lmask = (1 << lsh) - 1;
#pragma unroll
        for (int ai = 0; ai < 2; ++ai)
#pragma unroll
            for (int m = 0; m < 4; ++m) { const int row = row0 + ai * HALF + m * 16, rs = row - split, pos = rs & lmask;
                const int orow = dsh ? (row - pos) + ((pos & ((1 << dsh) - 1)) << (lsh - dsh)) + (pos >> dsh) : row;
                bf16_t* rowp = O + (size_t)orow * ldc + col0;
                const float rstd = rss ? 1.0f / sqrtf(rss[row] * (1.0f / 1024.0f) + 1e-6f) : 1.0f;
#pragma unroll
                for (int bj = 0; bj < 2; ++bj) { const f32x4 v0 = acc[ai][bj][m][0] * rstd, v1 = acc[ai][bj][m][1] * rstd;
                    u32x4 w; w.x = cvt_pk_bf16(v0[0], v0[1]); w.y = cvt_pk_bf16(v0[2], v0[3]); w.z = cvt_pk_bf16(v1[0], v1[1]); w.w = cvt_pk_bf16(v1[2], v1[3]);
                    *(u32x4*)(rowp + bj * HALF) = w; } }
    }
};
struct EpiSwiglu {
    static constexpr bool PERM = true, AFTER_DRAIN = false;
    bf16_t* O; int ldc; const float* rss;
    __device__ __forceinline__ static float act(float g, float up) { return g * up * __builtin_amdgcn_rcpf(1.0f + __builtin_amdgcn_exp2f(-1.44269504089f * g)); }
    __device__ __forceinline__ void operator()(const f32x4 (&acc)[2][2][4][2], const Unit& u, int wr, int wc, int fr, int fq) const {
        const int row0 = u.pm * BM + wr * 64 + fr; const int col0 = u.pn * HALF + wc * 32 + 8 * fq;
#pragma unroll
        for (int ai = 0; ai < 2; ++ai)
#pragma unroll
            for (int m = 0; m < 4; ++m) { const int row = row0 + ai * HALF + m * 16; bf16_t* rowp = O + (size_t)row * ldc + col0;
                const float rstd = rss ? 1.0f / sqrtf(rss[row] * (1.0f / 1024.0f) + 1e-6f) : 1.0f;
                const f32x4 g0 = acc[ai][0][m][0] * rstd, g1 = acc[ai][0][m][1] * rstd, u0 = acc[ai][1][m][0] * rstd, u1 = acc[ai][1][m][1] * rstd;
                u32x4 w; w.x = cvt_pk_bf16(act(g0[0], u0[0]), act(g0[1], u0[1])); w.y = cvt_pk_bf16(act(g0[2], u0[2]), act(g0[3], u0[3]));
                w.z = cvt_pk_bf16(act(g1[0], u1[0]), act(g1[1], u1[1])); w.w = cvt_pk_bf16(act(g1[2], u1[2]), act(g1[3], u1[3]));
                *(u32x4*)rowp = w; }
    }
};
struct EpiResid {
    static constexpr bool PERM = true, AFTER_DRAIN = false;
    const float* base0; const float* base1; int split; float* out; int ldc;
    bf16_t* Hn; const float* gn; float* rss;
    __device__ __forceinline__ void operator()(const f32x4 (&acc)[2][2][4][2], const Unit& u, int wr, int wc, int fr, int fq) const {
        const int row0 = u.pm * BM + wr * 64 + fr; const int col0 = u.pn * BM + wc * 32 + 8 * fq;
        const float* bb = (u.pm * BM < split) ? base0 : base1 - (size_t)split * ldc;
        f32x4 gv[2][2];
        if (Hn) {
#pragma unroll
            for (int bj = 0; bj < 2; ++bj) { gv[bj][0] = *(const f32x4*)(gn + col0 + bj * HALF); gv[bj][1] = *(const f32x4*)(gn + col0 + bj * HALF + 4); } }
#pragma unroll
        for (int ai = 0; ai < 2; ++ai)
#pragma unroll
            for (int m = 0; m < 4; ++m) { const int row = row0 + ai * HALF + m * 16; const size_t off = (size_t)row * ldc + col0; float ssq = 0.f;
#pragma unroll
                for (int bj = 0; bj < 2; ++bj) {
                    const f32x4 b0 = *(const f32x4*)(bb + off + bj * HALF), b1 = *(const f32x4*)(bb + off + bj * HALF + 4);
                    const f32x4 v0 = b0 + acc[ai][bj][m][0], v1 = b1 + acc[ai][bj][m][1];
                    *(f32x4*)(out + off + bj * HALF) = v0; *(f32x4*)(out + off + bj * HALF + 4) = v1;
                    if (Hn) { const f32x4 h0 = v0 * gv[bj][0], h1 = v1 * gv[bj][1];
                        u32x4 w; w.x = cvt_pk_bf16(h0[0], h0[1]); w.y = cvt_pk_bf16(h0[2], h0[3]); w.z = cvt_pk_bf16(h1[0], h1[1]); w.w = cvt_pk_bf16(h1[2], h1[3]);
                        *(u32x4*)(Hn + off + bj * HALF) = w;
                        ssq += (v0[0] * v0[0] + v0[1] * v0[1]) + (v0[2] * v0[2] + v0[3] * v0[3]) + (v1[0] * v1[0] + v1[1] * v1[1]) + (v1[2] * v1[2] + v1[3] * v1[3]); } }
                if (Hn) { ssq += __shfl_xor(ssq, 16); ssq += __shfl_xor(ssq, 32); if (fq == 0) unsafeAtomicAdd(rss + row, ssq); } }
    }
};


template <class Epi, class Sched, bool ALIGN_EPI = false, bool SP2 = false>
__device__ __forceinline__ void gemm_phase(PG8_LAS unsigned char* lds, const Gemm g, const Sched& S, const Epi& E, const int tid) {
    const int wid = __builtin_amdgcn_readfirstlane(tid >> 6), lane = tid & 63, wr = wid >> 2, wc = wid & 3, fr = lane & 15, fq = lane >> 4;
    const int K = g.K, nt = K / BK;
    unsigned voffA[2], voffB[2];
#pragma unroll
    for (int i = 0; i < 2; ++i) { int R, C; stage_rc(tid * 16 + i * 8192, R, C); const int Rb = Epi::PERM ? ((R & ~31) + perm32(R & 31)) : R;
        voffA[i] = (unsigned)(R * K + C) * 2u; voffB[i] = (unsigned)(Rb * K + C) * 2u; }
    const size_t kstep = (size_t)(BK * 2);
    const size_t hstep = (size_t)HALF * K * 2;
    const size_t tstep = 2 * hstep;
    const unsigned ldsw = (unsigned)wid * 1024u;
    const int aoff = lds_byte(wr * 64 + fr, fq * 8), boff = lds_byte(wc * 32 + fr, fq * 8);
#define PG8_SA(b, h) (((b) * 2 + (h)) * HTB)
#define PG8_SB(b, h) ((4 + (b) * 2 + (h)) * HTB)
#define PG8_STAGE(bufoff, gbase, voff) do { _Pragma("unroll") for (int _i = 0; _i < 2; ++_i) \
        __builtin_amdgcn_global_load_lds((const unsigned*)((const char*)(gbase) + (voff)[_i]), (PG8_LAS unsigned*)(lds + (bufoff) + ldsw + _i * 8192), 16, 0, 0); } while (0)
#define PG8_LDA(dst, b, h) do { _Pragma("unroll") for (int m = 0; m < 4; ++m) _Pragma("unroll") for (int k = 0; k < 2; ++k) dst[m][k] = *(const PG8_LAS bf16x8*)(lds + PG8_SA(b, h) + aoff + m * 2048 + k * 1024); } while (0)
#define PG8_LDB(dst, b, h) do { _Pragma("unroll") for (int n = 0; n < 2; ++n) _Pragma("unroll") for (int k = 0; k < 2; ++k) dst[n][k] = *(const PG8_LAS bf16x8*)(lds + PG8_SB(b, h) + boff + n * 2048 + k * 1024); } while (0)
#define PG8_MMA(ai, bj, At, Bt) do { __builtin_amdgcn_s_setprio(1); _Pragma("unroll") for (int m = 0; m < 4; ++m) _Pragma("unroll") for (int n = 0; n < 2; ++n) _Pragma("unroll") for (int k = 0; k < 2; ++k) \
        acc[ai][bj][m][n] = __builtin_amdgcn_mfma_f32_16x16x32_bf16(Bt[n][k], At[m][k], acc[ai][bj][m][n], 0, 0, 0); __builtin_amdgcn_s_setprio(0); } while (0)
#define PG8_WAIT_V(n) asm volatile("s_waitcnt vmcnt(" #n ")" ::: "memory")
#define PG8_WAIT_L(n) asm volatile("s_waitcnt lgkmcnt(" #n ")" ::: "memory")
#define PG8_BAR __builtin_amdgcn_s_barrier()
#define PG8_SCHED __builtin_amdgcn_sched_barrier(0)
    Unit cur, nxt; int ui = 0;
    if (!S.next(0, cur)) return;
    f32x4 acc[2][2][4][2];
#pragma unroll
    for (int a = 0; a < 2; ++a)
#pragma unroll
        for (int b = 0; b < 2; ++b)
#pragma unroll
            for (int m = 0; m < 4; ++m)
#pragma unroll
                for (int n = 0; n < 2; ++n) acc[a][b][m][n] = (f32x4){0.f, 0.f, 0.f, 0.f};
    bf16x8 At[4][2], B0[2][2], B1[2][2];
    const char* cA = (const char*)g.A + (size_t)cur.pm * tstep; const char* cB = (const char*)g.Bt + (size_t)cur.pn * tstep;
    S.a_ready(cur);
    if constexpr (SP2) {
        PG8_STAGE(PG8_SB(0, 0), cB, voffB); PG8_STAGE(PG8_SB(0, 1), cB + hstep, voffB); PG8_STAGE(PG8_SA(0, 0), cA, voffA); PG8_STAGE(PG8_SA(0, 1), cA + hstep, voffA);
        if (wr == 1) PG8_BAR;
        PG8_WAIT_V(2); PG8_BAR;
        PG8_STAGE(PG8_SB(1, 0), cB + kstep, voffB); PG8_STAGE(PG8_SA(1, 0), cA + kstep, voffA); PG8_STAGE(PG8_SB(1, 1), cB + hstep + kstep, voffB);
        PG8_WAIT_V(6); PG8_BAR;
    } else {
        PG8_STAGE(PG8_SB(0, 0), cB, voffB); PG8_STAGE(PG8_SA(0, 0), cA, voffA); PG8_STAGE(PG8_SB(0, 1), cB + hstep, voffB); PG8_STAGE(PG8_SA(0, 1), cA + hstep, voffA);
        if (wr == 1) PG8_BAR;
        PG8_WAIT_V(4); PG8_BAR;
        PG8_STAGE(PG8_SB(1, 0), cB + kstep, voffB); PG8_STAGE(PG8_SA(1, 0), cA + kstep, voffA); PG8_STAGE(PG8_SB(1, 1), cB + hstep + kstep, voffB);
        PG8_WAIT_V(6); PG8_BAR;
    }
    for (;;) {
        const bool has_next = S.next(ui + 1, nxt);
        const char* nA = has_next ? (const char*)g.A + (size_t)nxt.pm * tstep : cA; const char* nB = has_next ? (const char*)g.Bt + (size_t)nxt.pn * tstep : cB;
        for (int t = 0; t < nt; t += 2) {
            const bool last = (t == nt - 2);
            const char* a1 = cA + (size_t)(t + 1) * kstep;
            const char* a2 = last ? nA : cA + (size_t)(t + 2) * kstep; const char* b2 = last ? nB : cB + (size_t)(t + 2) * kstep;
            const char* a3 = a2 + kstep; const char* b3 = b2 + kstep;
            if (last && has_next) S.a_ready(nxt);
            if constexpr (SP2) {
            PG8_LDB(B0, 0, 0); PG8_LDB(B1, 0, 1); PG8_SCHED; PG8_LDA(At, 0, 0); PG8_STAGE(PG8_SA(1, 1), a1 + hstep, voffA);
            PG8_WAIT_V(8); PG8_WAIT_L(0); PG8_BAR; PG8_MMA(0, 0, At, B0); PG8_MMA(0, 1, At, B1); PG8_BAR; PG8_SCHED;
            PG8_LDA(At, 0, 1); PG8_STAGE(PG8_SB(0, 0), b2, voffB); PG8_STAGE(PG8_SB(0, 1), b2 + hstep, voffB); PG8_STAGE(PG8_SA(0, 0), a2, voffA);
            PG8_WAIT_V(8); PG8_WAIT_L(0); PG8_BAR; PG8_MMA(1, 0, At, B0); PG8_MMA(1, 1, At, B1); PG8_BAR; PG8_SCHED;
            PG8_LDB(B0, 1, 0); PG8_LDB(B1, 1, 1); PG8_SCHED; PG8_LDA(At, 1, 0); PG8_STAGE(PG8_SA(0, 1), a2 + hstep, voffA);
            PG8_WAIT_V(8); PG8_WAIT_L(0); PG8_BAR; PG8_MMA(0, 0, At, B0); PG8_MMA(0, 1, At, B1); PG8_BAR; PG8_SCHED;
            PG8_LDA(At, 1, 1); PG8_STAGE(PG8_SB(1, 0), b3, voffB); PG8_STAGE(PG8_SB(1, 1), b3 + hstep, voffB); PG8_STAGE(PG8_SA(1, 0), a3, voffA);
            PG8_WAIT_V(8); PG8_WAIT_L(0); PG8_BAR; PG8_MMA(1, 0, At, B0); PG8_MMA(1, 1, At, B1); PG8_BAR; PG8_SCHED;
            } else {
            PG8_LDB(B0, 0, 0); PG8_SCHED; PG8_LDA(At, 0, 0); PG8_STAGE(PG8_SA(1, 1), a1 + hstep, voffA);
            PG8_WAIT_L(8); PG8_BAR; PG8_WAIT_L(0); PG8_MMA(0, 0, At, B0); PG8_BAR; PG8_SCHED;
            PG8_LDB(B1, 0, 1); PG8_STAGE(PG8_SB(0, 0), b2, voffB);
            PG8_BAR; PG8_WAIT_L(0); PG8_MMA(0, 1, At, B1); PG8_BAR;
            PG8_LDA(At, 0, 1); PG8_STAGE(PG8_SA(0, 0), a2, voffA);
            PG8_BAR; PG8_WAIT_L(0); PG8_MMA(1, 0, At, B0); PG8_BAR; PG8_SCHED;
            PG8_STAGE(PG8_SB(0, 1), b2 + hstep, voffB);
            PG8_WAIT_V(6); PG8_BAR; PG8_MMA(1, 1, At, B1); PG8_BAR;
            PG8_LDB(B0, 1, 0); PG8_SCHED; PG8_LDA(At, 1, 0); PG8_STAGE(PG8_SA(0, 1), a2 + hstep, voffA);
            PG8_WAIT_L(8); PG8_BAR; PG8_WAIT_L(0); PG8_MMA(0, 0, At, B0); PG8_BAR; PG8_SCHED;
            PG8_LDB(B1, 1, 1); PG8_STAGE(PG8_SB(1, 0), b3, voffB);
            PG8_BAR; PG8_WAIT_L(0); PG8_MMA(0, 1, At, B1); PG8_BAR;
            PG8_LDA(At, 1, 1); PG8_STAGE(PG8_SA(1, 0), a3, voffA);
            PG8_BAR; PG8_WAIT_L(0); PG8_MMA(1, 0, At, B0); PG8_BAR; PG8_SCHED;
            PG8_STAGE(PG8_SB(1, 1), b3 + hstep, voffB);
            PG8_WAIT_V(6); PG8_BAR; PG8_MMA(1, 1, At, B1); PG8_BAR;
            }
        }
        if constexpr (ALIGN_EPI) { if (wr == 0) PG8_BAR; }
        if constexpr (!Epi::AFTER_DRAIN) { E(acc, cur, wr, wc, fr, fq); S.done(cur); }
        if (!has_next) break;
#pragma unroll
        for (int a = 0; a < 2; ++a)
#pragma unroll
            for (int b = 0; b < 2; ++b)
#pragma unroll
                for (int m = 0; m < 4; ++m)
#pragma unroll
                    for (int n = 0; n < 2; ++n) acc[a][b][m][n] = (f32x4){0.f, 0.f, 0.f, 0.f};
        cur = nxt; cA = nA; cB = nB; ++ui;
        if constexpr (ALIGN_EPI) { if (wr == 1) PG8_BAR; }
    }
    PG8_WAIT_V(0);
    if constexpr (!ALIGN_EPI) { if (wr == 0) PG8_BAR; }
    PG8_BAR;
    if constexpr (Epi::AFTER_DRAIN) { E.fused(acc, cur, wr, wc, fr, fq, lds, wid, lane); S.done(cur); }
#undef PG8_SA
#undef PG8_SB
#undef PG8_STAGE
#undef PG8_LDA
#undef PG8_LDB
#undef PG8_MMA
#undef PG8_WAIT_V
#undef PG8_WAIT_L
#undef PG8_BAR
#undef PG8_SCHED
}
}

constexpr int NWAVES = 8;
constexpr int D = 1024, DFF = 2816, NQKV = 1536;
constexpr int ROWS_P = 16 * 2048, ROWS_S = 8 * 8192, M = ROWS_P + ROWS_S;
constexpr float EPS = 1e-6f, LOG2E = 1.44269504089f;
#ifndef MK_SINGLE
#define MK_SINGLE 1
#endif
constexpr int NPHASES = 18;
#ifndef PROBE_DIAG
#define PROBE_DIAG 0
#endif
#ifndef REPEAT_N
#define REPEAT_N 4
#endif
#ifndef REPEAT_MASK
#define REPEAT_MASK 0
#endif

constexpr size_t MiB = 1u << 20;
constexpr size_t WS_WQKVA = 2 * MiB;
constexpr size_t WS_WOA   = 5 * MiB;
constexpr size_t WS_WQKVB = 7 * MiB;
constexpr size_t WS_WOB   = 16 * MiB;
constexpr size_t WS_WGU   = 18 * MiB;
constexpr size_t WS_WDN   = 40 * MiB;
constexpr size_t WS_H     = 64 * MiB;
constexpr size_t WS_QKV   = 256 * MiB;
constexpr size_t WS_O0    = 544 * MiB;
constexpr size_t WS_O1    = 736 * MiB;
constexpr size_t WS_LSE   = 928 * MiB;
constexpr size_t WS_ACT   = 256 * MiB;
constexpr size_t WS_RSS   = 940 * MiB;
constexpr size_t WS_END   = 944 * MiB;
static_assert(WS_ACT + (size_t)M * DFF * 2 <= WS_LSE && WS_LSE + (size_t)2 * M * 16 * 4 <= WS_END, "ws map");

constexpr int LDS_BYTES = 147456;

#define LAS __attribute__((address_space(3)))
typedef unsigned short bf16;
typedef float f32x4 __attribute__((ext_vector_type(4)));
typedef float f32x16 __attribute__((ext_vector_type(16)));
typedef short bf16x8 __attribute__((ext_vector_type(8)));
typedef short s16x4 __attribute__((ext_vector_type(4)));
typedef unsigned u32x4 __attribute__((ext_vector_type(4)));
typedef unsigned u32x2 __attribute__((ext_vector_type(2)));
using pg8::cvt_pk_bf16;
__device__ __forceinline__ float bf2f(short s) { return __builtin_bit_cast(float, (unsigned)(unsigned short)s << 16); }
__device__ __forceinline__ float wave_sum(float v) {
#pragma unroll
    for (int o = 1; o < 64; o <<= 1) v += __shfl_xor(v, o);
    return v;
}

struct Args { const float* in[16]; float* out; unsigned char* ws; int ph_lo, ph_hi; };

__device__ __forceinline__ void transpose_item(const float* W, int K, int N, bf16* WT, int k0, int n0, int drow0, LAS float* scr, int lane) {
#pragma unroll 8
    for (int i = 0; i < 32; ++i) { const int kk = 2 * i + (lane >> 5); scr[kk * 33 + (lane & 31)] = W[(size_t)(k0 + kk) * N + n0 + (lane & 31)]; }
    asm volatile("s_waitcnt lgkmcnt(0)" ::: "memory");
    const int c = lane & 7;
#pragma unroll
    for (int j = 0; j < 4; ++j) { const int n = (lane >> 3) + 8 * j; const LAS float* s = scr + (8 * c) * 33 + n;
        u32x4 o; o.x = cvt_pk_bf16(s[0 * 33], s[1 * 33]); o.y = cvt_pk_bf16(s[2 * 33], s[3 * 33]); o.z = cvt_pk_bf16(s[4 * 33], s[5 * 33]); o.w = cvt_pk_bf16(s[6 * 33], s[7 * 33]);
        *(u32x4*)(WT + (size_t)(drow0 + n) * K + k0 + 8 * c) = o; }
    asm volatile("s_waitcnt lgkmcnt(0)" ::: "memory");
}
__device__ __forceinline__ void prologue_weights(const Args& a, LAS unsigned char* lds, int gw, int NGW, int wave, int lane) {
    LAS float* scr = (LAS float*)(lds + wave * 16384);
    unsigned char* ws = a.ws;
    constexpr int I_QA = 16 * 48, I_O = 16 * 32, I_QB = 16 * 144, I_GU = 16 * 176, I_DN = 44 * 32;
    constexpr int NITEMS = I_QA + I_O + I_QB + I_O + 2 * I_GU + 2 * I_DN;
    for (int it = gw; it < NITEMS; it += NGW) {
        int r = it;
        if (r < I_QA) { transpose_item(a.in[5], D, NQKV, (bf16*)(ws + WS_WQKVA), 64 * (r / 48), 32 * (r % 48), 32 * (r % 48), scr, lane); continue; } r -= I_QA;
        if (r < I_O)  { transpose_item(a.in[9], D, D, (bf16*)(ws + WS_WOA), 64 * (r / 32), 32 * (r % 32), 32 * (r % 32), scr, lane); continue; } r -= I_O;
        if (r < I_QB) { transpose_item(a.in[10], D, 3 * NQKV, (bf16*)(ws + WS_WQKVB), 64 * (r / 144), 32 * (r % 144), 32 * (r % 144), scr, lane); continue; } r -= I_QB;
        if (r < I_O)  { transpose_item(a.in[13], D, D, (bf16*)(ws + WS_WOB), 64 * (r / 32), 32 * (r % 32), 32 * (r % 32), scr, lane); continue; } r -= I_O;
        if (r < 2 * I_GU) { const int l = r / I_GU; r -= l * I_GU; const int n0 = 32 * (r % 176); const int f = n0 < DFF ? n0 : n0 - DFF;
            const int drow = 256 * (f / 128) + (n0 < DFF ? 0 : 128) + (f % 128);
            transpose_item(a.in[14] + (size_t)l * D * 2 * DFF, D, 2 * DFF, (bf16*)(ws + WS_WGU) + (size_t)l * 2 * DFF * D, 64 * (r / 176), n0, drow, scr, lane); continue; } r -= 2 * I_GU;
        { const int l = r / I_DN; r -= l * I_DN;
            transpose_item(a.in[15] + (size_t)l * DFF * D, DFF, D, (bf16*)(ws + WS_WDN) + (size_t)l * D * DFF, 64 * (r / 32), 32 * (r % 32), 32 * (r % 32), scr, lane); }
    }
}
__device__ __forceinline__ void norm_phase(const float* x0, const float* x1, const float* g, bf16* H, int gw, int NGW, int lane) {
    f32x4 gv[4];
#pragma unroll
    for (int j = 0; j < 4; ++j) gv[j] = *(const f32x4*)(g + 4 * lane + 256 * j);
    for (int m = gw; m < M; m += NGW) {
        const float* xr = (m < ROWS_P) ? x0 + (size_t)m * D : x1 + (size_t)(m - ROWS_P) * D;
        f32x4 v[4]; float s = 0.f;
#pragma unroll
        for (int j = 0; j < 4; ++j) { v[j] = *(const f32x4*)(xr + 4 * lane + 256 * j); s += (v[j].x * v[j].x + v[j].y * v[j].y) + (v[j].z * v[j].z + v[j].w * v[j].w); }
        const float rstd = 1.0f / sqrtf(wave_sum(s) * (1.0f / D) + EPS);
        bf16* orow = H + (size_t)m * D + 4 * lane;
#pragma unroll
        for (int j = 0; j < 4; ++j) { const f32x4 t = v[j] * rstd * gv[j]; u32x2 o; o.x = cvt_pk_bf16(t.x, t.y); o.y = cvt_pk_bf16(t.z, t.w); *(u32x2*)(orow + 256 * j) = o; }
    }
}

__device__ __forceinline__ float xhalf_max(float m) { auto rr = __builtin_amdgcn_permlane32_swap(__builtin_bit_cast(unsigned, m), __builtin_bit_cast(unsigned, m), false, false); return fmaxf(__builtin_bit_cast(float, rr[0]), __builtin_bit_cast(float, rr[1])); }
__device__ __forceinline__ float xhalf_sum(float m) { auto rr = __builtin_amdgcn_permlane32_swap(__builtin_bit_cast(unsigned, m), __builtin_bit_cast(unsigned, m), false, false); return __builtin_bit_cast(float, rr[0]) + __builtin_bit_cast(float, rr[1]); }
struct AttU { int kvh, rowp, rown, Ls, t0; };
__device__ __forceinline__ AttU att_decode(int kvh, int tile, int dsh) {
    AttU a; a.kvh = kvh; int seq_row0, lsh, tin;
    if (tile < 512) { seq_row0 = (tile >> 5) * 2048; lsh = 11; tin = tile & 31; }
    else { const int t2 = tile - 512; seq_row0 = ROWS_P + (t2 >> 7) * 8192; lsh = 13; tin = t2 & 127; }
    const int tsh = lsh - dsh - 6, r = tin >> tsh; a.Ls = 1 << (lsh - dsh); a.rown = seq_row0 + r; a.rowp = seq_row0 + r * a.Ls; a.t0 = (tin & ((1 << tsh) - 1)) * 64; return a;
}
__device__ __forceinline__ bool att_unit(int i, int G, int bid, int& kvh, int& tile) {
    constexpr int NT = 16 * 32 + 8 * 128;
    if (G == 256) { const int xcd = bid & 7; kvh = xcd & 3; tile = (2 * i + (xcd >> 2)) * 32 + (bid >> 3); return tile < NT; }
    const int u = bid + i * G; kvh = u & 3; tile = u >> 2; return tile < NT;
}
template <int HW, int MODE, int DIAG = 0>
__device__ __forceinline__ void attn_phase(LAS unsigned char* lds, const bf16* __restrict__ QKV, bf16* O, const bf16* P1, float* LSEw, const float* LSE0, const float* LSE1,
                                           int dsh, const float* gq, const float* gk, const float* sink, const float* rel_table, int G, int bid, const int tid) {
    constexpr int NK = 64 + 2 * HW, KST = 144, VST = NK * 2 + 8, TBN = 2 * HW + 64, NPASS = NK / 64;
    constexpr int NVIT = NK * 2, NVI = (NVIT + 511) / 512;
    constexpr int KS_OFF = 0, VT_OFF = NK * KST, TB_OFF = VT_OFF + 64 * VST, GQ_OFF = TB_OFF + 16 * TBN * 4;
    static_assert(GQ_OFF + 256 + 16 <= 131072, "attention LDS");
    const int lane = tid & 63, w = __builtin_amdgcn_readfirstlane(tid >> 6), hh = w >> 1, half = w & 1;
    const int ql = lane & 31, g2 = lane >> 5;
    const int skk = tid >> 3, sdc = tid & 7;
    float gkr[8];
#pragma unroll
    for (int i = 0; i < 8; ++i) gkr[i] = gk[sdc * 8 + i];
    LAS float* Tb = (LAS float*)(lds + TB_OFF);
    LAS float* Gq = (LAS float*)(lds + GQ_OFF);
    LAS float* Sh = (LAS float*)(lds + GQ_OFF + 256);
    if (tid < 64) Gq[tid] = gq[tid] * (0.125f * LOG2E);
    int tb_kvh = -1;
    bf16x8 kraw[NPASS], vraw[NVI][4], qr[4];
#define ATT_LOADS(au) do { \
        const bf16* base_ = QKV + (size_t)(au).rowp * NQKV; \
          \
        _Pragma("unroll") for (int p = 0; p < NPASS; ++p) { int t = (au).t0 - HW + p * 64 + skk; t = t < 0 ? 0 : (t >= (au).Ls ? (au).Ls - 1 : t); \
            kraw[p] = *(const bf16x8*)(base_ + (size_t)t * NQKV + D + (au).kvh * 64 + sdc * 8); } \
        _Pragma("unroll") for (int iv = 0; iv < NVI; ++iv) { const int it = tid + 512 * iv, kg = (it < NVIT ? it : tid) >> 3; \
            _Pragma("unroll") for (int jj = 0; jj < 4; ++jj) { int t = (au).t0 - HW + 4 * kg + jj; t = t < 0 ? 0 : (t >= (au).Ls ? (au).Ls - 1 : t); \
                vraw[iv][jj] = *(const bf16x8*)(base_ + (size_t)t * NQKV + D + 256 + (au).kvh * 64 + sdc * 8); } } \
        { const bf16* qp_ = base_ + (size_t)((au).t0 + 32 * half + ql) * NQKV + ((au).kvh * 4 + hh) * 64 + 8 * g2; \
            _Pragma("unroll") for (int ks = 0; ks < 4; ++ks) qr[ks] = *(const bf16x8*)(qp_ + 16 * ks); } \
    } while (0)
    int ui = 0, ukvh, utile;
    bool have = att_unit(0, G, bid, ukvh, utile);
    AttU cu = att_decode(have ? ukvh : 0, have ? utile : 0, dsh);
    ATT_LOADS(cu);
    for (; have; ++ui) {
        const int kvh = cu.kvh, t0 = cu.t0, Ls = cu.Ls;
        const int h = kvh * 4 + hh;
        const int rowq = cu.rown + ((t0 + 32 * half + ql) << dsh);
        if (kvh != tb_kvh) {
            float gqm = 0.f, gkm = 0.f;
            for (int i = 0; i < 64; ++i) { gqm = fmaxf(gqm, fabsf(gq[i])); gkm = fmaxf(gkm, fabsf(gk[i])); }
            float sh[4];
#pragma unroll
            for (int hq = 0; hq < 4; ++hq) { float bm = -1e30f; for (int b = 0; b < 32; ++b) bm = fmaxf(bm, rel_table[b * 16 + kvh * 4 + hq]); sh[hq] = (8.0f * gqm * gkm + bm) * LOG2E; }
            if (tid < 4) Sh[tid] = tid == 0 ? sh[0] : tid == 1 ? sh[1] : tid == 2 ? sh[2] : sh[3];
            for (int e = tid; e < 16 * TBN; e += NWAVES * 64) {
                const int hq = e / (4 * TBN), b4 = (e / TBN) & 3, j = e % TBN, idx = j + 3 - b4, rel = idx - 31 - HW; float v = -1e30f;
                if (rel >= -HW && rel <= HW) { const int off = rel * (1 << dsh), n = off < 0 ? -off : off;
                    int b = n < 8 ? n : (n < 15 ? 8 : n < 27 ? 9 : n < 50 ? 10 : n < 91 ? 11 : n < 166 ? 12 : n < 305 ? 13 : n < 559 ? 14 : 15);
                    b += off > 0 ? 16 : 0; v = rel_table[b * 16 + kvh * 4 + hq] * LOG2E - (hq == 0 ? sh[0] : hq == 1 ? sh[1] : hq == 2 ? sh[2] : sh[3]); }
                Tb[e] = v; }
            tb_kvh = kvh;
        }
        if (DIAG >= 3) { _Pragma("unroll") for (int p = 0; p < NPASS; ++p) asm volatile("" :: "v"(kraw[p])); _Pragma("unroll") for (int iv = 0; iv < NVI; ++iv) _Pragma("unroll") for (int jj = 0; jj < 4; ++jj) asm volatile("" :: "v"(vraw[iv][jj])); }
        if (DIAG < 3)
#pragma unroll
        for (int p = 0; p < NPASS; ++p) {
            const int kk = p * 64 + skk; float f[8]; float ss = 0.f;
#pragma unroll
            for (int j = 0; j < 8; ++j) { f[j] = bf2f(kraw[p][j]); ss += f[j] * f[j]; }
            ss += __shfl_xor(ss, 1); ss += __shfl_xor(ss, 2); ss += __shfl_xor(ss, 4);
            const float rs = 1.0f / sqrtf(ss * (1.0f / 64.0f) + EPS);
            u32x4 pk; pk.x = cvt_pk_bf16(f[0] * rs * gkr[0], f[1] * rs * gkr[1]); pk.y = cvt_pk_bf16(f[2] * rs * gkr[2], f[3] * rs * gkr[3]);
            pk.z = cvt_pk_bf16(f[4] * rs * gkr[4], f[5] * rs * gkr[5]); pk.w = cvt_pk_bf16(f[6] * rs * gkr[6], f[7] * rs * gkr[7]);
            *(LAS u32x4*)(lds + KS_OFF + kk * KST + sdc * 16) = pk;
        }
        if (DIAG < 3)
#pragma unroll
        for (int iv = 0; iv < NVI; ++iv) { const int it = tid + 512 * iv, kg = it >> 3;
            if (it < NVIT) {
#pragma unroll
                for (int j = 0; j < 8; ++j) { const s16x4 t4 = {vraw[iv][0][j], vraw[iv][1][j], vraw[iv][2][j], vraw[iv][3][j]};
                    *(LAS s16x4*)(lds + VT_OFF + (sdc * 8 + j) * VST + kg * 8) = t4; } } }
        __syncthreads();
        bf16x8 qf[4];
        {
            float ss = 0.f;
#pragma unroll
            for (int ks = 0; ks < 4; ++ks)
#pragma unroll
                for (int j = 0; j < 8; ++j) { const float f = bf2f(qr[ks][j]); ss += f * f; }
            ss += __shfl_xor(ss, 32);
            const float rs = 1.0f / sqrtf(ss * (1.0f / 64.0f) + EPS);
#pragma unroll
            for (int ks = 0; ks < 4; ++ks) { const f32x4 ga = *(const LAS f32x4*)(Gq + 16 * ks + 8 * g2), gb = *(const LAS f32x4*)(Gq + 16 * ks + 8 * g2 + 4); u32x4 pk;
                pk.x = cvt_pk_bf16(bf2f(qr[ks][0]) * rs * ga[0], bf2f(qr[ks][1]) * rs * ga[1]); pk.y = cvt_pk_bf16(bf2f(qr[ks][2]) * rs * ga[2], bf2f(qr[ks][3]) * rs * ga[3]);
                pk.z = cvt_pk_bf16(bf2f(qr[ks][4]) * rs * gb[0], bf2f(qr[ks][5]) * rs * gb[1]); pk.w = cvt_pk_bf16(bf2f(qr[ks][6]) * rs * gb[2], bf2f(qr[ks][7]) * rs * gb[3]);
                qf[ks] = __builtin_bit_cast(bf16x8, pk); }
        }
        { int nk, nt; have = att_unit(ui + 1, G, bid, nk, nt); if (have) cu = att_decode(nk, nt, dsh); ATT_LOADS(cu); }
        f32x16 o0, o1;
#pragma unroll
        for (int i = 0; i < 16; ++i) { o0[i] = 0.f; o1[i] = 0.f; }
        float lsum = 0.f; const float mrun = Sh[hh];
        int c_lo = half, c_hi = half + HW / 16;
        { const int lo2 = (HW - t0 + 31) >> 5, hi2 = ((Ls + HW - t0) >> 5) - 1; c_lo = lo2 > c_lo ? lo2 : c_lo; c_hi = hi2 < c_hi ? hi2 : c_hi; }
        if (DIAG >= 2) c_hi = c_lo - 1;
        const LAS unsigned char* kbase = lds + KS_OFF + ql * KST + 16 * g2;
        const LAS float* tbase = Tb + (hh * 4 + (ql & 3)) * TBN + 28 - (ql & ~3) + 4 * g2 - 32 * half;
        const LAS unsigned char* vbase = lds + VT_OFF + ql * VST + 8 * g2;
        bf16x8 ka[4];
#pragma unroll
        for (int ks = 0; ks < 4; ++ks) ka[ks] = *(const LAS bf16x8*)(kbase + c_lo * 32 * KST + 32 * ks);
        for (int c = c_lo; c <= c_hi; ++c) {
            f32x4 bz[4]; s16x4 vf[2][4]; bf16x8 kn[4];
#pragma unroll
            for (int q4 = 0; q4 < 4; ++q4) bz[q4] = *(const LAS f32x4*)(tbase + 32 * c + 8 * q4);
            const int cn = c < c_hi ? c + 1 : c;
#pragma unroll
            for (int ks = 0; ks < 4; ++ks) kn[ks] = *(const LAS bf16x8*)(kbase + cn * 32 * KST + 32 * ks);
#pragma unroll
            for (int mt = 0; mt < 2; ++mt)
#pragma unroll
                for (int j = 0; j < 4; ++j) vf[mt][j] = *(const LAS s16x4*)(vbase + mt * 32 * VST + c * 64 + 16 * j);
            __builtin_amdgcn_sched_barrier(0);
            f32x16 s;
#pragma unroll
            for (int i = 0; i < 16; ++i) s[i] = 0.f;
#pragma unroll
            for (int ks = 0; ks < 4; ++ks) s = __builtin_amdgcn_mfma_f32_32x32x16_bf16(ka[ks], qf[ks], s, 0, 0, 0);
#pragma unroll
            for (int i = 0; i < 16; ++i) { s[i] = __builtin_amdgcn_exp2f(s[i] + bz[i >> 2][i & 3]); lsum += s[i]; }
            u32x4 pa, pb;
            pa.x = cvt_pk_bf16(s[0], s[1]); pa.y = cvt_pk_bf16(s[2], s[3]); pa.z = cvt_pk_bf16(s[4], s[5]); pa.w = cvt_pk_bf16(s[6], s[7]);
            pb.x = cvt_pk_bf16(s[8], s[9]); pb.y = cvt_pk_bf16(s[10], s[11]); pb.z = cvt_pk_bf16(s[12], s[13]); pb.w = cvt_pk_bf16(s[14], s[15]);
            const bf16x8 p0 = __builtin_bit_cast(bf16x8, pa), p1 = __builtin_bit_cast(bf16x8, pb);
            o0 = __builtin_amdgcn_mfma_f32_32x32x16_bf16(__builtin_shufflevector(vf[0][0], vf[0][1], 0, 1, 2, 3, 4, 5, 6, 7), p0, o0, 0, 0, 0);
            o1 = __builtin_amdgcn_mfma_f32_32x32x16_bf16(__builtin_shufflevector(vf[1][0], vf[1][1], 0, 1, 2, 3, 4, 5, 6, 7), p0, o1, 0, 0, 0);
            o0 = __builtin_amdgcn_mfma_f32_32x32x16_bf16(__builtin_shufflevector(vf[0][2], vf[0][3], 0, 1, 2, 3, 4, 5, 6, 7), p1, o0, 0, 0, 0);
            o1 = __builtin_amdgcn_mfma_f32_32x32x16_bf16(__builtin_shufflevector(vf[1][2], vf[1][3], 0, 1, 2, 3, 4, 5, 6, 7), p1, o1, 0, 0, 0);
#pragma unroll
            for (int ks = 0; ks < 4; ++ks) ka[ks] = kn[ks];
        }
        lsum += __shfl_xor(lsum, 32);
        if (MODE == 0) lsum += __builtin_amdgcn_exp2f(sink[h] * LOG2E - mrun);
        float f0 = 0.f, f1 = 0.f, f2 = 1.0f / lsum;
        if (MODE == 1 && DIAG == 0) { if (g2 == 0) LSEw[(size_t)rowq * 16 + h] = mrun + __builtin_amdgcn_logf(lsum); }
        if (MODE == 2) {
            const float l2 = mrun + __builtin_amdgcn_logf(lsum), l0 = LSE0[(size_t)rowq * 16 + h], l1 = LSE1[(size_t)rowq * 16 + h];
            const float mm = fmaxf(l2, fmaxf(l0, l1)), w0 = __builtin_amdgcn_exp2f(l0 - mm), w1 = __builtin_amdgcn_exp2f(l1 - mm), w2 = __builtin_amdgcn_exp2f(l2 - mm);
            const float iw = 1.0f / (w0 + w1 + w2); f0 = w0 * iw; f1 = w1 * iw; f2 = w2 * iw / lsum;
        }
        bf16* op = O + (size_t)rowq * D + h * 64 + 4 * g2;
        const bf16* pp = P1 + (size_t)rowq * D + h * 64 + 4 * g2;
#pragma unroll
        for (int mt = 0; mt < 2; ++mt)
#pragma unroll
            for (int q4 = 0; q4 < 4; ++q4) {
                float v[4];
#pragma unroll
                for (int j = 0; j < 4; ++j) v[j] = (mt == 0 ? o0[4 * q4 + j] : o1[4 * q4 + j]) * f2;
                if (MODE == 2) { const s16x4 a = *(const s16x4*)(op + mt * 32 + 8 * q4), b = *(const s16x4*)(pp + mt * 32 + 8 * q4);
#pragma unroll
                    for (int j = 0; j < 4; ++j) v[j] += f0 * bf2f(a[j]) + f1 * bf2f(b[j]); }
                u32x2 o; o.x = cvt_pk_bf16(v[0], v[1]); o.y = cvt_pk_bf16(v[2], v[3]);
                if (DIAG == 0) *(u32x2*)(op + mt * 32 + 8 * q4) = o; else asm volatile("" :: "v"(o));
            }
        __syncthreads();
    }
#undef ATT_LOADS
}


__global__ void __launch_bounds__(NWAVES * 64, 2) fwd_megakernel(Args a) {
    extern __shared__ __attribute__((aligned(16))) unsigned char lds_raw[];
    LAS unsigned char* lds = (LAS unsigned char*)lds_raw;
    cg::grid_group grid = cg::this_grid();
    const int G = gridDim.x, bid = blockIdx.x;
    unsigned char* ws = a.ws;
    bf16* H = (bf16*)(ws + WS_H); bf16* QKV = (bf16*)(ws + WS_QKV); bf16* O0 = (bf16*)(ws + WS_O0); bf16* O1 = (bf16*)(ws + WS_O1); bf16* ACT = (bf16*)(ws + WS_ACT);
    float* LSE0 = (float*)(ws + WS_LSE); float* LSE1 = LSE0 + (size_t)M * 16;
    const float* xin0 = a.in[0]; const float* xin1 = a.in[1]; float* out = a.out;
    float* RSS = (float*)(ws + WS_RSS);

    for (int ph = a.ph_lo, rep = 0; ph < a.ph_hi;) {
        int tid = threadIdx.x; asm volatile("" : "+v"(tid));
        const int lane = tid & 63, wave = __builtin_amdgcn_readfirstlane(tid >> 6), gw = bid * NWAVES + wave, NGW = G * NWAVES;
        if (ph == 0) { for (int i = gw * 64 + lane; i < 3 * M; i += NGW * 64) RSS[i] = 0.f;
            prologue_weights(a, lds, gw, NGW, wave, lane); norm_phase(xin0, xin1, a.in[3], H, gw, NGW, lane); }
        else if (ph == 4 || ph == 7 || ph == 15) { ++ph; continue; }
        else if (ph == 1 || ph == 8 || ph == 10 || ph == 12) {
            const bf16* Bt = ph == 1 ? (const bf16*)(ws + WS_WQKVA) : (const bf16*)(ws + WS_WQKVB) + (size_t)((ph - 8) >> 1) * NQKV * D;
            pg8::Gemm g{H, Bt, M, NQKV, D}; pg8::StaticOrder S; S.init(M, NQKV, G, bid);
            pg8::EpiBf16 E{QKV, NQKV, ph == 10 ? 2 : ph == 12 ? 4 : 0, ROWS_P, ph == 1 ? nullptr : RSS + M};
            pg8::gemm_phase<pg8::EpiBf16, pg8::StaticOrder, true, true>(lds, g, S, E, tid);
        }
        else if (ph == 2) attn_phase<128, 0>(lds, QKV, O0, nullptr, nullptr, nullptr, nullptr, 0, a.in[6], a.in[7], a.in[8], a.in[2], G, bid, tid);
        else if (ph == 9 || ph == 11) {
            const int gi = (ph - 9) >> 1;
#if PROBE_DIAG
            if (rep >= 1) attn_phase<64, 1, PROBE_DIAG>(lds, QKV, gi ? O1 : O0, nullptr, gi ? LSE1 : LSE0, nullptr, nullptr, 2 * gi, a.in[11] + 64 * gi, a.in[12] + 64 * gi, nullptr, a.in[2], G, bid, tid); else
#endif
            attn_phase<64, 1>(lds, QKV, gi ? O1 : O0, nullptr, gi ? LSE1 : LSE0, nullptr, nullptr, 2 * gi, a.in[11] + 64 * gi, a.in[12] + 64 * gi, nullptr, a.in[2], G, bid, tid);
        }
        else if (ph == 13) attn_phase<64, 2>(lds, QKV, O0, O1, nullptr, LSE0, LSE1, 4, a.in[11] + 128, a.in[12] + 128, nullptr, a.in[2], G, bid, tid);
        else if (ph == 3 || ph == 14 || ph == 6 || ph == 17) {
            const bool isdown = (ph == 6 || ph == 17);
            const bf16* A = isdown ? ACT : O0;
            const bf16* Bt = ph == 3 ? (const bf16*)(ws + WS_WOA) : ph == 14 ? (const bf16*)(ws + WS_WOB) : (const bf16*)(ws + WS_WDN) + (size_t)(ph == 17 ? 1 : 0) * D * DFF;
            pg8::Gemm g{A, Bt, M, D, isdown ? DFF : D}; pg8::StaticOrder S; S.init(M, D, G, bid);
            const float* gn = ph == 3 ? a.in[4] : ph == 6 ? a.in[3] + D : a.in[4] + D; const int rk = ph == 3 ? 0 : ph == 6 ? 1 : 2;
            pg8::EpiResid E{ph == 3 ? xin0 : out, ph == 3 ? xin1 : out + (size_t)ROWS_P * D, ROWS_P, out, D, ph == 17 ? nullptr : H, gn, RSS + (size_t)rk * M};
            pg8::gemm_phase<pg8::EpiResid, pg8::StaticOrder, true, true>(lds, g, S, E, tid);
        }
        else {
            const bf16* Bt = (const bf16*)(ws + WS_WGU) + (size_t)(ph == 16 ? 1 : 0) * 2 * DFF * D;
            pg8::Gemm g{H, Bt, M, 2 * DFF, D}; pg8::StaticOrder S; S.init(M, 2 * DFF, G, bid);
            pg8::EpiSwiglu E{ACT, DFF, RSS + (size_t)(ph == 16 ? 2 : 0) * M};
            pg8::gemm_phase<pg8::EpiSwiglu, pg8::StaticOrder, true, true>(lds, g, S, E, tid);
        }
        const bool again = ((REPEAT_MASK >> ph) & 1) && rep < REPEAT_N;
        if (ph + 1 < a.ph_hi || again) grid.sync();
        if (again) ++rep; else { rep = 0; ++ph; }
    }
}

extern "C" void kernel_launch(void* const* d_in, const int* in_sizes, int n_in, void* d_out, int out_size, void* d_ws, size_t ws_size, hipStream_t stream) {
    static int grid = 0;
    if (grid == 0) {
        if (n_in != 16 || out_size != M * D || ws_size < WS_END) { fprintf(stderr, "kernel_launch: unexpected shapes (n_in %d out %d ws %zu)\n", n_in, out_size, ws_size); grid = -1; return; }
        int dev = 0, cus = 0, per_cu = 0;
        hipGetDevice(&dev); hipDeviceGetAttribute(&cus, hipDeviceAttributeMultiprocessorCount, dev);
        if (hipFuncSetAttribute((const void*)fwd_megakernel, hipFuncAttributeMaxDynamicSharedMemorySize, LDS_BYTES) != hipSuccess) { fprintf(stderr, "kernel_launch: hipFuncSetAttribute failed\n"); grid = -1; return; }
        hipOccupancyMaxActiveBlocksPerMultiprocessor(&per_cu, (const void*)fwd_megakernel, NWAVES * 64, LDS_BYTES);
        if (per_cu < 1) { fprintf(stderr, "kernel_launch: occupancy query says %d blocks/CU\n", per_cu); per_cu = 1; }
        (void)hipGetLastError();
        grid = cus;
    }
    if (grid < 0) return;
    Args a{};
    for (int i = 0; i < 16; ++i) a.in[i] = (const float*)d_in[i];
    a.out = (float*)d_out; a.ws = (unsigned char*)d_ws;
#if MK_SINGLE
    a.ph_lo = 0; a.ph_hi = NPHASES;
    void* kargs[] = {&a};
    hipError_t e = hipLaunchCooperativeKernel((const void*)fwd_megakernel, dim3(grid), dim3(NWAVES * 64), kargs, LDS_BYTES, stream);
    if (e != hipSuccess) fprintf(stderr, "kernel_launch: cooperative launch failed: %s (grid %d)\n", hipGetErrorString(e), grid);
#else
    for (int ph = 0; ph < NPHASES; ++ph) { a.ph_lo = ph; a.ph_hi = ph + 1; hipLaunchKernelGGL(fwd_megakernel, dim3(grid), dim3(NWAVES * 64), LDS_BYTES, stream, a); }
#endif
}
```

```cpp
#include <hip/hip_runtime.h>
#include <hip/hip_cooperative_groups.h>
#include <cstdio>
#include <cstdint>
namespace cg = cooperative_groups;
namespace pg8 {
#define PG8_LAS __attribute__((address_space(3)))
typedef unsigned short bf16_t;
typedef short bf16x8 __attribute__((ext_vector_type(8)));
typedef float f32x4 __attribute__((ext_vector_type(4)));
typedef unsigned u32x4 __attribute__((ext_vector_type(4)));
constexpr int BM = 256, BK = 64, HALF = 128, HTB = HALF * BK * 2  , STAGE_BYTES = 8 * HTB, NXCD = 8, WGM = 8;

__host__ __device__ __forceinline__ int lds_byte(int r, int c) { const int st = (r >> 4) * 2 + (c >> 5), rr = r & 15, cc = c & 31, ob = rr * 64 + cc * 2; return st * 1024 + (ob ^ (((ob >> 9) & 1) << 5)); }
__host__ __device__ __forceinline__ void stage_rc(int b, int& R, int& C) { const int st = b / 1024, sb = b % 1024, swz = sb ^ (((sb >> 9) & 1) << 5); R = (st >> 1) * 16 + swz / 64; C = (st & 1) * 32 + (swz % 64) / 2; }
__host__ __device__ __forceinline__ int perm32(int rho) { const int n = rho >> 4, i = rho & 15; return 8 * (i >> 2) + 4 * n + (i & 3); }

struct Unit { int pm, pn; };
struct Gemm { const bf16_t* A; const bf16_t* Bt; int M, N, K; };

struct StaticOrder {
    int nM, nN, nwg, G, c;
    __host__ __device__ void init(int M, int N, int G_, int c_) { nM = M / BM; nN = N / BM; nwg = nM * nN; G = G_; c = c_; }
    __host__ __device__ bool next(int i, Unit& u) const {
        const long L = (long)i * G + c; if (L >= nwg) return false;
        int wgid = (int)L; { const int q = nwg / NXCD, r = nwg % NXCD, xcd = wgid % NXCD, off = wgid / NXCD; wgid = (xcd < r ? xcd * (q + 1) : r * (q + 1) + (xcd - r) * q) + off; }
        const int nig = WGM * nN, gid = wgid / nig, fm = gid * WGM, gsz = (nM - fm) < WGM ? (nM - fm) : WGM;
        u.pm = fm + ((wgid % nig) % gsz); u.pn = (wgid % nig) / gsz; return true;
    }
    __device__ __forceinline__ void a_ready(const Unit&) const {}
    __device__ __forceinline__ void done(const Unit&) const {}
};

typedef __bf16 bf16x2_hw __attribute__((ext_vector_type(2)));
typedef float f32x2_hw __attribute__((ext_vector_type(2)));
__device__ __forceinline__ unsigned cvt_pk_bf16(float lo, float hi) { f32x2_hw v = {lo, hi}; bf16x2_hw b = __builtin_convertvector(v, bf16x2_hw); return __builtin_bit_cast(unsigned, b); }

struct EpiBf16 {
    static constexpr bool PERM = true, AFTER_DRAIN = false;
    bf16_t* O; int ldc; int dsh; int split;
    int nostore;
    const float* rss;
    __device__ __forceinline__ void operator()(const f32x4 (&acc)[2][2][4][2], const Unit& u, int wr, int wc, int fr, int fq) const {
        const int row0 = u.pm * BM + wr * 64 + fr; const int col0 = u.pn * BM + wc * 64 + 8 * fq;
        const int lsh = (u.pm * BM < split) ? 11 : 13, lmask = (1 << lsh) - 1;
        float rstd[2][4];
        if (rss) { f32x4 pv[2][4];
#pragma unroll
            for (int ai = 0; ai < 2; ++ai)
#pragma unroll
                for (int m = 0; m < 4; ++m) pv[ai][m] = *(const f32x4*)(rss + (size_t)(row0 + ai * HALF + m * 16) * 16 + 4 * fq);
#pragma unroll
            for (int ai = 0; ai < 2; ++ai)
#pragma unroll
                for (int m = 0; m < 4; ++m) { float t = (pv[ai][m][0] + pv[ai][m][1]) + (pv[ai][m][2] + pv[ai][m][3]); t += __shfl_xor(t, 16); t += __shfl_xor(t, 32); rstd[ai][m] = __builtin_amdgcn_rsqf(t * (1.0f / 1024.0f) + 1e-6f); }
        } else {
#pragma unroll
            for (int ai = 0; ai < 2; ++ai)
#pragma unroll
                for (int m = 0; m < 4; ++m) rstd[ai][m] = 1.0f; }
#pragma unroll
        for (int ai = 0; ai < 2; ++ai)
#pragma unroll
            for (int m = 0; m < 4; ++m) { const int row = row0 + ai * HALF + m * 16, rs = row - split, pos = rs & lmask;
                const int orow = dsh ? (row - pos) + ((pos & ((1 << dsh) - 1)) << (lsh - dsh)) + (pos >> dsh) : row;
                bf16_t* rowp = O + (size_t)orow * ldc + col0;
#pragma unroll
                for (int bj = 0; bj < 2; ++bj) { const f32x4 v0 = acc[ai][bj][m][0] * rstd[ai][m], v1 = acc[ai][bj][m][1] * rstd[ai][m];
                    u32x4 w; w.x = cvt_pk_bf16(v0[0], v0[1]); w.y = cvt_pk_bf16(v0[2], v0[3]); w.z = cvt_pk_bf16(v1[0], v1[1]); w.w = cvt_pk_bf16(v1[2], v1[3]);
                    if (!nostore) *(u32x4*)(rowp + bj * 32) = w;
                    else if (nostore == 2) { const int lane_ = fr + 16 * fq, wv_ = wr * 4 + wc; *(u32x4*)(O + (size_t)(u.pm * 6 + u.pn) * 65536 + wv_ * 8192 + ((ai * 4 + m) * 2 + bj) * 512 + lane_ * 8) = w; }
                    else asm volatile("" :: "v"(w)); } }
    }
};
struct EpiSwiglu {
    static constexpr bool PERM = true, AFTER_DRAIN = false;
    bf16_t* O; int ldc; const float* rss;
    __device__ __forceinline__ static float act(float g, float up) { return g * up * __builtin_amdgcn_rcpf(1.0f + __builtin_amdgcn_exp2f(-1.44269504089f * g)); }
    __device__ __forceinline__ void operator()(const f32x4 (&acc)[2][2][4][2], const Unit& u, int wr, int wc, int fr, int fq) const {
        const int row0 = u.pm * BM + wr * 64 + fr; const int col0 = u.pn * HALF + wc * 32 + 8 * fq;
        float rstd[2][4];
        { f32x4 pv[2][4];
#pragma unroll
            for (int ai = 0; ai < 2; ++ai)
#pragma unroll
                for (int m = 0; m < 4; ++m) pv[ai][m] = *(const f32x4*)(rss + (size_t)(row0 + ai * HALF + m * 16) * 16 + 4 * fq);
#pragma unroll
            for (int ai = 0; ai < 2; ++ai)
#pragma unroll
                for (int m = 0; m < 4; ++m) { float t = (pv[ai][m][0] + pv[ai][m][1]) + (pv[ai][m][2] + pv[ai][m][3]); t += __shfl_xor(t, 16); t += __shfl_xor(t, 32); rstd[ai][m] = __builtin_amdgcn_rsqf(t * (1.0f / 1024.0f) + 1e-6f); } }
#pragma unroll
        for (int ai = 0; ai < 2; ++ai)
#pragma unroll
            for (int m = 0; m < 4; ++m) { const int row = row0 + ai * HALF + m * 16; bf16_t* rowp = O + (size_t)row * ldc + col0;
                const float r = rstd[ai][m];
                const f32x4 g0 = acc[ai][0][m][0] * r, g1 = acc[ai][0][m][1] * r, u0 = acc[ai][1][m][0] * r, u1 = acc[ai][1][m][1] * r;
                u32x4 w; w.x = cvt_pk_bf16(act(g0[0], u0[0]), act(g0[1], u0[1])); w.y = cvt_pk_bf16(act(g0[2], u0[2]), act(g0[3], u0[3]));
                w.z = cvt_pk_bf16(act(g1[0], u1[0]), act(g1[1], u1[1])); w.w = cvt_pk_bf16(act(g1[2], u1[2]), act(g1[3], u1[3]));
                *(u32x4*)rowp = w; }
    }
};
struct EpiResid {
    static constexpr bool PERM = true, AFTER_DRAIN = false;
    const float* base0; const float* base1; int split; int base_f32; int out_f32;
    bf16_t* X; float* out; int ldc; float* rss;
    __device__ __forceinline__ void operator()(const f32x4 (&acc)[2][2][4][2], const Unit& u, int wr, int wc, int fr, int fq) const {
        const int row0 = u.pm * BM + wr * 64 + fr; const int col0 = u.pn * BM + wc * 64 + 8 * fq;
        const float* bb = (u.pm * BM < split) ? base0 : base1 - (size_t)split * ldc;
#define RES_ROW(ai, m, B00, B01, B10, B11) do { const int row = row0 + (ai) * HALF + (m) * 16; const size_t off = (size_t)row * ldc + col0; float ssq = 0.f; \
            _Pragma("unroll") for (int bj = 0; bj < 2; ++bj) { \
                const f32x4 v0 = (bj ? (B10) : (B00)) + acc[ai][bj][m][0], v1 = (bj ? (B11) : (B01)) + acc[ai][bj][m][1]; \
                if (out_f32) { *(f32x4*)(out + off + bj * 32) = v0; *(f32x4*)(out + off + bj * 32 + 4) = v1; } \
                else { u32x4 w; w.x = cvt_pk_bf16(v0[0], v0[1]); w.y = cvt_pk_bf16(v0[2], v0[3]); w.z = cvt_pk_bf16(v1[0], v1[1]); w.w = cvt_pk_bf16(v1[2], v1[3]); \
                    *(u32x4*)(X + off + bj * 32) = w; \
                    ssq += (v0[0] * v0[0] + v0[1] * v0[1]) + (v0[2] * v0[2] + v0[3] * v0[3]) + (v1[0] * v1[0] + v1[1] * v1[1]) + (v1[2] * v1[2] + v1[3] * v1[3]); } } \
            if (!out_f32) { ssq += __shfl_xor(ssq, 16); ssq += __shfl_xor(ssq, 32); if (fq == 0) rss[(size_t)row * 16 + u.pn * 4 + wc] = ssq; } } while (0)
#define BF_LO(w) __builtin_bit_cast(float, (w) << 16)
#define BF_HI(w) __builtin_bit_cast(float, (w) & 0xffff0000u)
        if (base_f32) {
            f32x4 bq[2][2][2][2];
#define RES_LOAD(buf, t) do { _Pragma("unroll") for (int r_ = 0; r_ < 2; ++r_) { const size_t off_ = (size_t)(row0 + ((t) >> 1) * HALF + (2 * ((t) & 1) + r_) * 16) * ldc + col0; \
                _Pragma("unroll") for (int bj = 0; bj < 2; ++bj) { bq[buf][r_][bj][0] = *(const f32x4*)(bb + off_ + bj * 32); bq[buf][r_][bj][1] = *(const f32x4*)(bb + off_ + bj * 32 + 4); } } } while (0)
            RES_LOAD(0, 0);
#pragma unroll
            for (int t = 0; t < 4; ++t) {
                if (t + 1 < 4) { if ((t & 1) == 0) RES_LOAD(1, t + 1); else RES_LOAD(0, t + 1); }
#pragma unroll
                for (int r_ = 0; r_ < 2; ++r_) RES_ROW(t >> 1, 2 * (t & 1) + r_, bq[t & 1][r_][0][0], bq[t & 1][r_][0][1], bq[t & 1][r_][1][0], bq[t & 1][r_][1][1]);
            }
#undef RES_LOAD
        } else {
            u32x4 raw[2][4][2];
#define RAW_LOAD(ai, m) do { _Pragma("unroll") for (int bj = 0; bj < 2; ++bj) raw[ai][m][bj] = *(const u32x4*)(X + (size_t)(row0 + (ai) * HALF + (m) * 16) * ldc + col0 + bj * 32); } while (0)
#define RAW_ROW(ai, m) do { const u32x4 w0 = raw[ai][m][0], w1 = raw[ai][m][1]; \
                RES_ROW(ai, m, ((f32x4){BF_LO(w0.x), BF_HI(w0.x), BF_LO(w0.y), BF_HI(w0.y)}), ((f32x4){BF_LO(w0.z), BF_HI(w0.z), BF_LO(w0.w), BF_HI(w0.w)}), \
                               ((f32x4){BF_LO(w1.x), BF_HI(w1.x), BF_LO(w1.y), BF_HI(w1.y)}), ((f32x4){BF_LO(w1.z), BF_HI(w1.z), BF_LO(w1.w), BF_HI(w1.w)})); } while (0)
            RAW_LOAD(0, 0); RAW_LOAD(0, 1); RAW_LOAD(0, 2); RAW_LOAD(0, 3);
            RAW_LOAD(1, 0); RAW_LOAD(1, 1);
            RAW_ROW(0, 0); RAW_ROW(0, 1);
            RAW_LOAD(1, 2); RAW_LOAD(1, 3);
            RAW_ROW(0, 2); RAW_ROW(0, 3); RAW_ROW(1, 0); RAW_ROW(1, 1); RAW_ROW(1, 2); RAW_ROW(1, 3);
#undef RAW_LOAD
#undef RAW_ROW
        }
#undef BF_LO
#undef BF_HI
#undef RES_ROW
    }
};


template <class Epi, class Sched, bool ALIGN_EPI = false, bool SP2 = false>
__device__ __forceinline__ void gemm_phase(PG8_LAS unsigned char* lds, const Gemm g, const Sched& S, const Epi& E, const int tid, const int stagger_ticks) {
    { const unsigned grp = blockIdx.x & 7u;     if (grp && stagger_ticks > 0) { const unsigned long long t0_ = __builtin_amdgcn_s_memrealtime(), want_ = (unsigned long long)(grp * (unsigned)stagger_ticks);
        while (__builtin_amdgcn_s_memrealtime() - t0_ < want_) __builtin_amdgcn_s_sleep(8); } }
    const int wid = __builtin_amdgcn_readfirstlane(tid >> 6), lane = tid & 63, wr = wid >> 2, wc = wid & 3, fr = lane & 15, fq = lane >> 4;
    const int K = g.K, nt = K / BK;
    unsigned voffA[2], voffB[2];
#pragma unroll
    for (int i = 0; i < 2; ++i) { int R, C; stage_rc(tid * 16 + i * 8192, R, C); const int Rb = Epi::PERM ? ((R & ~31) + perm32(R & 31)) : R;
        voffA[i] = (unsigned)(R * K + C) * 2u; voffB[i] = (unsigned)(Rb * K + C) * 2u; }
    const size_t kstep = (size_t)(BK * 2);
    const size_t hstep = (size_t)HALF * K * 2;
    const size_t tstep = 2 * hstep;
    const unsigned ldsw = (unsigned)wid * 1024u;
    const int aoff = lds_byte(wr * 64 + fr, fq * 8), boff = lds_byte(wc * 32 + fr, fq * 8);
#define PG8_SA(b, h) (((b) * 2 + (h)) * HTB)
#define PG8_SB(b, h) ((4 + (b) * 2 + (h)) * HTB)
#define PG8_STAGE(bufoff, gbase, voff) do { _Pragma("unroll") for (int _i = 0; _i < 2; ++_i) \
        __builtin_amdgcn_global_load_lds((const unsigned*)((const char*)(gbase) + (voff)[_i]), (PG8_LAS unsigned*)(lds + (bufoff) + ldsw + _i * 8192), 16, 0, 0); } while (0)
#define PG8_LDA(dst, b, h) do { _Pragma("unroll") for (int m = 0; m < 4; ++m) _Pragma("unroll") for (int k = 0; k < 2; ++k) dst[m][k] = *(const PG8_LAS bf16x8*)(lds + PG8_SA(b, h) + aoff + m * 2048 + k * 1024); } while (0)
#define PG8_LDB(dst, b, h) do { _Pragma("unroll") for (int n = 0; n < 2; ++n) _Pragma("unroll") for (int k = 0; k < 2; ++k) dst[n][k] = *(const PG8_LAS bf16x8*)(lds + PG8_SB(b, h) + boff + n * 2048 + k * 1024); } while (0)
#define PG8_MMA(ai, bj, At, Bt) do { __builtin_amdgcn_s_setprio(1); _Pragma("unroll") for (int m = 0; m < 4; ++m) _Pragma("unroll") for (int n = 0; n < 2; ++n) _Pragma("unroll") for (int k = 0; k < 2; ++k) \
        acc[ai][bj][m][n] = __builtin_amdgcn_mfma_f32_16x16x32_bf16(Bt[n][k], At[m][k], acc[ai][bj][m][n], 0, 0, 0); __builtin_amdgcn_s_setprio(0); } while (0)
#define PG8_WAIT_V(n) asm volatile("s_waitcnt vmcnt(" #n ")" ::: "memory")
#define PG8_WAIT_L(n) asm volatile("s_waitcnt lgkmcnt(" #n ")" ::: "memory")
#define PG8_BAR __builtin_amdgcn_s_barrier()
#define PG8_SCHED __builtin_amdgcn_sched_barrier(0)
    Unit cur, nxt; int ui = 0;
    if (!S.next(0, cur)) return;
    f32x4 acc[2][2][4][2];
#pragma unroll
    for (int a = 0; a < 2; ++a)
#pragma unroll
        for (int b = 0; b < 2; ++b)
#pragma unroll
            for (int m = 0; m < 4; ++m)
#pragma unroll
                for (int n = 0; n < 2; ++n) acc[a][b][m][n] = (f32x4){0.f, 0.f, 0.f, 0.f};
    bf16x8 At[4][2], B0[2][2], B1[2][2];
    const char* cA = (const char*)g.A + (size_t)cur.pm * tstep; const char* cB = (const char*)g.Bt + (size_t)cur.pn * tstep;
    S.a_ready(cur);
    if constexpr (SP2) {
        PG8_STAGE(PG8_SB(0, 0), cB, voffB); PG8_STAGE(PG8_SB(0, 1), cB + hstep, voffB); PG8_STAGE(PG8_SA(0, 0), cA, voffA); PG8_STAGE(PG8_SA(0, 1), cA + hstep, voffA);
        if (wr == 1) PG8_BAR;
        PG8_WAIT_V(2); PG8_BAR;
        PG8_STAGE(PG8_SB(1, 0), cB + kstep, voffB); PG8_STAGE(PG8_SA(1, 0), cA + kstep, voffA); PG8_STAGE(PG8_SB(1, 1), cB + hstep + kstep, voffB);
        PG8_WAIT_V(6); PG8_BAR;
    } else {
        PG8_STAGE(PG8_SB(0, 0), cB, voffB); PG8_STAGE(PG8_SA(0, 0), cA, voffA); PG8_STAGE(PG8_SB(0, 1), cB + hstep, voffB); PG8_STAGE(PG8_SA(0, 1), cA + hstep, voffA);
        if (wr == 1) PG8_BAR;
        PG8_WAIT_V(4); PG8_BAR;
        PG8_STAGE(PG8_SB(1, 0), cB + kstep, voffB); PG8_STAGE(PG8_SA(1, 0), cA + kstep, voffA); PG8_STAGE(PG8_SB(1, 1), cB + hstep + kstep, voffB);
        PG8_WAIT_V(6); PG8_BAR;
    }
    for (;;) {
        const bool has_next = S.next(ui + 1, nxt);
        const char* nA = has_next ? (const char*)g.A + (size_t)nxt.pm * tstep : cA; const char* nB = has_next ? (const char*)g.Bt + (size_t)nxt.pn * tstep : cB;
        for (int t = 0; t < nt; t += 2) {
            const bool last = (t == nt - 2);
            const char* a1 = cA + (size_t)(t + 1) * kstep;
            const char* a2 = last ? nA : cA + (size_t)(t + 2) * kstep; const char* b2 = last ? nB : cB + (size_t)(t + 2) * kstep;
            const char* a3 = a2 + kstep; const char* b3 = b2 + kstep;
            if (last && has_next) S.a_ready(nxt);
            if constexpr (SP2) {
            PG8_LDB(B0, 0, 0); PG8_LDB(B1, 0, 1); PG8_SCHED; PG8_LDA(At, 0, 0); PG8_STAGE(PG8_SA(1, 1), a1 + hstep, voffA);
            PG8_WAIT_V(8); PG8_WAIT_L(0); PG8_BAR; PG8_MMA(0, 0, At, B0); PG8_MMA(0, 1, At, B1); PG8_BAR; PG8_SCHED;
            PG8_LDA(At, 0, 1); PG8_STAGE(PG8_SB(0, 0), b2, voffB); PG8_STAGE(PG8_SB(0, 1), b2 + hstep, voffB); PG8_STAGE(PG8_SA(0, 0), a2, voffA);
            PG8_WAIT_V(8); PG8_WAIT_L(0); PG8_BAR; PG8_MMA(1, 0, At, B0); PG8_MMA(1, 1, At, B1); PG8_BAR; PG8_SCHED;
            PG8_LDB(B0, 1, 0); PG8_LDB(B1, 1, 1); PG8_SCHED; PG8_LDA(At, 1, 0); PG8_STAGE(PG8_SA(0, 1), a2 + hstep, voffA);
            PG8_WAIT_V(8); PG8_WAIT_L(0); PG8_BAR; PG8_MMA(0, 0, At, B0); PG8_MMA(0, 1, At, B1); PG8_BAR; PG8_SCHED;
            PG8_LDA(At, 1, 1); PG8_STAGE(PG8_SB(1, 0), b3, voffB); PG8_STAGE(PG8_SB(1, 1), b3 + hstep, voffB); PG8_STAGE(PG8_SA(1, 0), a3, voffA);
            PG8_WAIT_V(8); PG8_WAIT_L(0); PG8_BAR; PG8_MMA(1, 0, At, B0); PG8_MMA(1, 1, At, B1); PG8_BAR; PG8_SCHED;
            } else {
            PG8_LDB(B0, 0, 0); PG8_SCHED; PG8_LDA(At, 0, 0); PG8_STAGE(PG8_SA(1, 1), a1 + hstep, voffA);
            PG8_WAIT_L(8); PG8_BAR; PG8_WAIT_L(0); PG8_MMA(0, 0, At, B0); PG8_BAR; PG8_SCHED;
            PG8_LDB(B1, 0, 1); PG8_STAGE(PG8_SB(0, 0), b2, voffB);
            PG8_BAR; PG8_WAIT_L(0); PG8_MMA(0, 1, At, B1); PG8_BAR;
            PG8_LDA(At, 0, 1); PG8_STAGE(PG8_SA(0, 0), a2, voffA);
            PG8_BAR; PG8_WAIT_L(0); PG8_MMA(1, 0, At, B0); PG8_BAR; PG8_SCHED;
            PG8_STAGE(PG8_SB(0, 1), b2 + hstep, voffB);
            PG8_WAIT_V(6); PG8_BAR; PG8_MMA(1, 1, At, B1); PG8_BAR;
            PG8_LDB(B0, 1, 0); PG8_SCHED; PG8_LDA(At, 1, 0); PG8_STAGE(PG8_SA(0, 1), a2 + hstep, voffA);
            PG8_WAIT_L(8); PG8_BAR; PG8_WAIT_L(0); PG8_MMA(0, 0, At, B0); PG8_BAR; PG8_SCHED;
            PG8_LDB(B1, 1, 1); PG8_STAGE(PG8_SB(1, 0), b3, voffB);
            PG8_BAR; PG8_WAIT_L(0); PG8_MMA(0, 1, At, B1); PG8_BAR;
            PG8_LDA(At, 1, 1); PG8_STAGE(PG8_SA(1, 0), a3, voffA);
            PG8_BAR; PG8_WAIT_L(0); PG8_MMA(1, 0, At, B0); PG8_BAR; PG8_SCHED;
            PG8_STAGE(PG8_SB(1, 1), b3 + hstep, voffB);
            PG8_WAIT_V(6); PG8_BAR; PG8_MMA(1, 1, At, B1); PG8_BAR;
            }
        }
        if constexpr (ALIGN_EPI) { if (wr == 0) PG8_BAR; }
        if constexpr (!Epi::AFTER_DRAIN) { E(acc, cur, wr, wc, fr, fq); S.done(cur); }
        if (!has_next) break;
#pragma unroll
        for (int a = 0; a < 2; ++a)
#pragma unroll
            for (int b = 0; b < 2; ++b)
#pragma unroll
                for (int m = 0; m < 4; ++m)
#pragma unroll
                    for (int n = 0; n < 2; ++n) acc[a][b][m][n] = (f32x4){0.f, 0.f, 0.f, 0.f};
        cur = nxt; cA = nA; cB = nB; ++ui;
        if constexpr (ALIGN_EPI) { if (wr == 1) PG8_BAR; }
    }
    PG8_WAIT_V(0);
    if constexpr (!ALIGN_EPI) { if (wr == 0) PG8_BAR; }
    PG8_BAR;
    if constexpr (Epi::AFTER_DRAIN) { E.fused(acc, cur, wr, wc, fr, fq, lds, wid, lane); S.done(cur); }
#undef PG8_SA
#undef PG8_SB
#undef PG8_STAGE
#undef PG8_LDA
#undef PG8_LDB
#undef PG8_MMA
#undef PG8_WAIT_V
#undef PG8_WAIT_L
#undef PG8_BAR
#undef PG8_SCHED
}
}

constexpr int NWAVES = 8;
constexpr int D = 1024, DFF = 2816, NQKV = 1536;
constexpr int ROWS_P = 16 * 2048, ROWS_S = 8 * 8192, M = ROWS_P + ROWS_S;
constexpr float EPS = 1e-6f, LOG2E = 1.44269504089f;
#ifndef MK_SINGLE
#define MK_SINGLE 1
#endif
constexpr int NPHASES = 18;
constexpr int STAGGER_RESID = 0, STAGGER_BF16 = 0;
#ifndef PROBE_MSPLIT
#define PROBE_MSPLIT 0
#endif
#ifndef PROBE_NOBAR
#define PROBE_NOBAR 0
#endif
#ifndef PROBE_NOSTORE
#define PROBE_NOSTORE 0
#endif
#ifndef PROBE_SYNCS
#define PROBE_SYNCS 0
#endif
#ifndef PROBE_DIAG
#define PROBE_DIAG 0
#endif
#ifndef REPEAT_N
#define REPEAT_N 4
#endif
#ifndef REPEAT_MASK
#define REPEAT_MASK 0
#endif

constexpr size_t MiB = 1u << 20;
constexpr size_t WS_CTL = 0, CTL_ZERO_BYTES = 16384;
constexpr size_t WS_WQKVA = 2 * MiB;
constexpr size_t WS_WOA   = 5 * MiB;
constexpr size_t WS_WQKVB = 7 * MiB;
constexpr size_t WS_WOB   = 16 * MiB;
constexpr size_t WS_WGU   = 18 * MiB;
constexpr size_t WS_WDN   = 40 * MiB;
constexpr size_t WS_H     = 64 * MiB;
constexpr size_t WS_QKV   = 256 * MiB;
constexpr size_t WS_O0    = 544 * MiB;
constexpr size_t WS_O1    = 736 * MiB;
constexpr size_t WS_LSE   = 928 * MiB;
constexpr size_t WS_ACT   = 256 * MiB;
constexpr size_t WS_RSS   = 944 * MiB;
constexpr size_t WS_END   = 964 * MiB;
static_assert(WS_ACT + (size_t)M * DFF * 2 <= WS_LSE && WS_LSE + (size_t)2 * M * 16 * 4 <= WS_RSS && WS_RSS + (size_t)3 * M * 64 <= WS_END && WS_END <= 1024 * MiB, "ws map");

constexpr int LDS_BYTES = 147456;

#define LAS __attribute__((address_space(3)))
typedef unsigned short bf16;
typedef float f32x4 __attribute__((ext_vector_type(4)));
typedef float f32x16 __attribute__((ext_vector_type(16)));
typedef short bf16x8 __attribute__((ext_vector_type(8)));
typedef short s16x4 __attribute__((ext_vector_type(4)));
typedef unsigned u32x4 __attribute__((ext_vector_type(4)));
typedef unsigned u32x2 __attribute__((ext_vector_type(2)));
typedef float f32x2p __attribute__((ext_vector_type(2)));
using pg8::cvt_pk_bf16;
__device__ __forceinline__ float bf2f(short s) { return __builtin_bit_cast(float, (unsigned)(unsigned short)s << 16); }
__device__ __forceinline__ float wave_sum(float v) {
#pragma unroll
    for (int o = 1; o < 64; o <<= 1) v += __shfl_xor(v, o);
    return v;
}

struct Args { const float* in[16]; float* out; unsigned char* ws; int ph_lo, ph_hi; };

__device__ __forceinline__ int colperm_row(int n0) { const int cl = n0 & 255, b = cl >> 5; return (n0 - cl) + 128 * (b & 1) + 32 * (b >> 1); }
__device__ __forceinline__ void transpose_item(const float* W, int K, int N, bf16* WT, int k0, int n0, int drow0, LAS float* scr, int lane, const float* gfold = nullptr) {
    f32x4 wv[8];
#pragma unroll
    for (int i = 0; i < 8; ++i) wv[i] = *(const f32x4*)(W + (size_t)(k0 + 8 * i + (lane >> 3)) * N + n0 + 4 * (lane & 7));
#pragma unroll
    for (int i = 0; i < 8; ++i) { const int kk = 8 * i + (lane >> 3); const float gf = gfold ? gfold[k0 + kk] : 1.0f; LAS float* d = scr + kk * 33 + 4 * (lane & 7);
        d[0] = wv[i].x * gf; d[1] = wv[i].y * gf; d[2] = wv[i].z * gf; d[3] = wv[i].w * gf; }
    asm volatile("s_waitcnt lgkmcnt(0)" ::: "memory");
    const int c = lane & 7;
#pragma unroll
    for (int j = 0; j < 4; ++j) { const int n = (lane >> 3) + 8 * j; const LAS float* s = scr + (8 * c) * 33 + n;
        u32x4 o; o.x = cvt_pk_bf16(s[0 * 33], s[1 * 33]); o.y = cvt_pk_bf16(s[2 * 33], s[3 * 33]); o.z = cvt_pk_bf16(s[4 * 33], s[5 * 33]); o.w = cvt_pk_bf16(s[6 * 33], s[7 * 33]);
        *(u32x4*)(WT + (size_t)(drow0 + n) * K + k0 + 8 * c) = o; }
    asm volatile("s_waitcnt lgkmcnt(0)" ::: "memory");
}
__device__ __forceinline__ void prologue_weights(const Args& a, LAS unsigned char* lds, int gw, int NGW, int wave, int lane) {
    LAS float* scr = (LAS float*)(lds + wave * 16384);
    unsigned char* ws = a.ws;
    constexpr int I_QA = 16 * 48, I_O = 16 * 32, I_QB = 16 * 144, I_GU = 16 * 176, I_DN = 44 * 32;
    constexpr int NITEMS = I_QA + I_O + I_QB + I_O + 2 * I_GU + 2 * I_DN;
    for (int it = gw; it < NITEMS; it += NGW) {
        int r = it;
        if (r < I_QA) { transpose_item(a.in[5], D, NQKV, (bf16*)(ws + WS_WQKVA), 64 * (r / 48), 32 * (r % 48), colperm_row(32 * (r % 48)), scr, lane); continue; } r -= I_QA;
        if (r < I_O)  { transpose_item(a.in[9], D, D, (bf16*)(ws + WS_WOA), 64 * (r / 32), 32 * (r % 32), colperm_row(32 * (r % 32)), scr, lane); continue; } r -= I_O;
        if (r < I_QB) { transpose_item(a.in[10], D, 3 * NQKV, (bf16*)(ws + WS_WQKVB), 64 * (r / 144), 32 * (r % 144), colperm_row(32 * (r % 144)), scr, lane, a.in[3] + D); continue; } r -= I_QB;
        if (r < I_O)  { transpose_item(a.in[13], D, D, (bf16*)(ws + WS_WOB), 64 * (r / 32), 32 * (r % 32), colperm_row(32 * (r % 32)), scr, lane); continue; } r -= I_O;
        if (r < 2 * I_GU) { const int l = r / I_GU; r -= l * I_GU; const int n0 = 32 * (r % 176); const int f = n0 < DFF ? n0 : n0 - DFF;
            const int drow = 256 * (f / 128) + (n0 < DFF ? 0 : 128) + (f % 128);
            transpose_item(a.in[14] + (size_t)l * D * 2 * DFF, D, 2 * DFF, (bf16*)(ws + WS_WGU) + (size_t)l * 2 * DFF * D, 64 * (r / 176), n0, drow, scr, lane, a.in[4] + l * D); continue; } r -= 2 * I_GU;
        { const int l = r / I_DN; r -= l * I_DN;
            transpose_item(a.in[15] + (size_t)l * DFF * D, DFF, D, (bf16*)(ws + WS_WDN) + (size_t)l * D * DFF, 64 * (r / 32), 32 * (r % 32), colperm_row(32 * (r % 32)), scr, lane); }
    }
}
__device__ __forceinline__ void norm_phase(const float* x0, const float* x1, const float* g, bf16* H, int gw, int NGW, int lane) {
    f32x4 gv[4];
#pragma unroll
    for (int j = 0; j < 4; ++j) gv[j] = *(const f32x4*)(g + 4 * lane + 256 * j);
    for (int m0 = gw; m0 < M; m0 += 2 * NGW) {
        const int m1 = m0 + NGW; const bool has1 = m1 < M; const int m1c = has1 ? m1 : m0;
        const float* xr0 = (m0 < ROWS_P) ? x0 + (size_t)m0 * D : x1 + (size_t)(m0 - ROWS_P) * D;
        const float* xr1 = (m1c < ROWS_P) ? x0 + (size_t)m1c * D : x1 + (size_t)(m1c - ROWS_P) * D;
        f32x4 v[4], w[4]; float s = 0.f, t = 0.f;
#pragma unroll
        for (int j = 0; j < 4; ++j) { v[j] = *(const f32x4*)(xr0 + 4 * lane + 256 * j); w[j] = *(const f32x4*)(xr1 + 4 * lane + 256 * j); }
#pragma unroll
        for (int j = 0; j < 4; ++j) { s += (v[j].x * v[j].x + v[j].y * v[j].y) + (v[j].z * v[j].z + v[j].w * v[j].w); t += (w[j].x * w[j].x + w[j].y * w[j].y) + (w[j].z * w[j].z + w[j].w * w[j].w); }
        const float rstd0 = __builtin_amdgcn_rsqf(wave_sum(s) * (1.0f / D) + EPS), rstd1 = __builtin_amdgcn_rsqf(wave_sum(t) * (1.0f / D) + EPS);
        bf16* orow0 = H + (size_t)m0 * D + 4 * lane; bf16* orow1 = H + (size_t)m1c * D + 4 * lane;
#pragma unroll
        for (int j = 0; j < 4; ++j) { const f32x4 a_ = v[j] * rstd0 * gv[j]; u32x2 o; o.x = cvt_pk_bf16(a_.x, a_.y); o.y = cvt_pk_bf16(a_.z, a_.w); *(u32x2*)(orow0 + 256 * j) = o; }
        if (has1) {
#pragma unroll
            for (int j = 0; j < 4; ++j) { const f32x4 a_ = w[j] * rstd1 * gv[j]; u32x2 o; o.x = cvt_pk_bf16(a_.x, a_.y); o.y = cvt_pk_bf16(a_.z, a_.w); *(u32x2*)(orow1 + 256 * j) = o; } }
    }
}

__device__ __forceinline__ float xhalf_max(float m) { auto rr = __builtin_amdgcn_permlane32_swap(__builtin_bit_cast(unsigned, m), __builtin_bit_cast(unsigned, m), false, false); return fmaxf(__builtin_bit_cast(float, rr[0]), __builtin_bit_cast(float, rr[1])); }
__device__ __forceinline__ float xhalf_sum(float m) { auto rr = __builtin_amdgcn_permlane32_swap(__builtin_bit_cast(unsigned, m), __builtin_bit_cast(unsigned, m), false, false); return __builtin_bit_cast(float, rr[0]) + __builtin_bit_cast(float, rr[1]); }
struct AttU { int kvh, rowp, rown, Ls, t0; };
__device__ __forceinline__ AttU att_decode(int kvh, int tile, int dsh) {
    AttU a; a.kvh = kvh; int seq_row0, lsh, tin;
    if (tile < 512) { seq_row0 = (tile >> 5) * 2048; lsh = 11; tin = tile & 31; }
    else { const int t2 = tile - 512; seq_row0 = ROWS_P + (t2 >> 7) * 8192; lsh = 13; tin = t2 & 127; }
    const int tsh = lsh - dsh - 6, r = tin >> tsh; a.Ls = 1 << (lsh - dsh); a.rown = seq_row0 + r; a.rowp = seq_row0 + r * a.Ls; a.t0 = (tin & ((1 << tsh) - 1)) * 64; return a;
}
__device__ __forceinline__ bool att_unit(int i, int G, int bid, int& kvh, int& tile) {
    constexpr int NT = 16 * 32 + 8 * 128;
    if (G == 256) { const int xcd = bid & 7; kvh = xcd & 3; tile = (2 * i + (xcd >> 2)) * 32 + (bid >> 3); return tile < NT; }
    const int u = bid + i * G; kvh = u & 3; tile = u >> 2; return tile < NT;
}
template <int HW, int MODE, int DIAG = 0>
__device__ __forceinline__ void attn_phase(LAS unsigned char* lds, const bf16* __restrict__ QKV, bf16* O, const bf16* P1, float* LSEw, const float* LSE0, const float* LSE1,
                                           int dsh, const float* gq, const float* gk, const float* sink, const float* rel_table, int G, int bid, const int tid) {
    constexpr int NK = 64 + 2 * HW, KST = 144, VST = NK * 2 + 8, TBN = 2 * HW + 64 + 16, NPASS = NK / 64;
    constexpr int NVIT = NK * 2, NVI = (NVIT + 511) / 512;
    constexpr int KS_OFF = 0, VT_OFF = NK * KST, TB_OFF = VT_OFF + 64 * VST, GQ_OFF = TB_OFF + 16 * TBN * 4;
    constexpr bool LTR = true;
    constexpr int OST_OFF = GQ_OFF + 512, OST_W = 32 * 144;
    static_assert(OST_OFF + 8 * OST_W <= LDS_BYTES - 64, "attention LDS (the grid barrier's two words sit in the last 64 bytes)");
    const int lane = tid & 63, w = __builtin_amdgcn_readfirstlane(tid >> 6), hh = w >> 1, half = w & 1;
    const int ql = lane & 31, g2 = lane >> 5;
    const int skk = tid >> 3, sdc = tid & 7;
    float gkr[8];
#pragma unroll
    for (int i = 0; i < 8; ++i) gkr[i] = gk[sdc * 8 + i];
    LAS float* Tb = (LAS float*)(lds + TB_OFF);
    LAS float* Gq = (LAS float*)(lds + GQ_OFF);
    LAS float* Sh = (LAS float*)(lds + GQ_OFF + 256);
    if (tid < 64) Gq[tid] = gq[tid] * (0.125f * LOG2E);
    int tb_kvh = -1;
    bf16x8 kraw[NPASS], vraw[NVI][4], qr[4];
    u32x4 pra[4], prb[4]; float pl0 = 0.f, pl1 = 0.f;
#define ATT_LOADS(au) do { \
        const bf16* base_ = QKV + (size_t)(au).rowp * NQKV; \
          \
        _Pragma("unroll") for (int p = 0; p < NPASS; ++p) { int t = (au).t0 - HW + p * 64 + skk; t = t < 0 ? 0 : (t >= (au).Ls ? (au).Ls - 1 : t); \
            kraw[p] = *(const bf16x8*)(base_ + (size_t)t * NQKV + D + (au).kvh * 64 + sdc * 8); } \
        _Pragma("unroll") for (int iv = 0; iv < NVI; ++iv) { const int it = tid + 512 * iv, kg = (it < NVIT ? it : tid) >> 3; \
            _Pragma("unroll") for (int jj = 0; jj < 4; ++jj) { int t = (au).t0 - HW + 4 * kg + jj; t = t < 0 ? 0 : (t >= (au).Ls ? (au).Ls - 1 : t); \
                vraw[iv][jj] = *(const bf16x8*)(base_ + (size_t)t * NQKV + D + 256 + (au).kvh * 64 + sdc * 8); } } \
        { const bf16* qp_ = base_ + (size_t)((au).t0 + 32 * half + ql) * NQKV + ((au).kvh * 4 + hh) * 64 + 8 * g2; \
            _Pragma("unroll") for (int ks = 0; ks < 4; ++ks) qr[ks] = *(const bf16x8*)(qp_ + 16 * ks); } \
        if (MODE == 2) { const size_t rq_ = (size_t)((au).rown + (((au).t0 + 32 * half + ql) << dsh)); const int h_ = (au).kvh * 4 + hh; \
            const size_t ro_ = ((size_t)((au).rown + (((au).t0 + 32 * half + (lane >> 3)) << dsh)) * D + h_ * 64 + 8 * (lane & 7)); \
            _Pragma("unroll") for (int it = 0; it < 4; ++it) { pra[it] = *(const u32x4*)(O + ro_ + ((size_t)(8 * it) << dsh) * D); prb[it] = *(const u32x4*)(P1 + ro_ + ((size_t)(8 * it) << dsh) * D); } \
            pl0 = LSE0[rq_ * 16 + h_]; pl1 = LSE1[rq_ * 16 + h_]; } \
    } while (0)
    constexpr bool DEFER = (MODE == 1);
    float lse_st = 0.f; float* lp_st = nullptr; bool have_st = false; int rb_st = 0, h_st = 0;
    LAS unsigned char* ostw = lds + OST_OFF + w * OST_W;
#define ATT_ROWS_OUT(rb, hd) do { if (DIAG == 0) { _Pragma("unroll") for (int it = 0; it < 4; ++it) { const int r_ = 8 * it + (lane >> 3), ch_ = lane & 7; \
        const u32x4 d_ = *(const LAS u32x4*)(ostw + r_ * 144 + ch_ * 16); *(u32x4*)(O + (size_t)((rb) + (r_ << dsh)) * D + (hd) * 64 + ch_ * 8) = d_; } } } while (0)
#define ATT_FLUSH() do { if (have_st) { ATT_ROWS_OUT(rb_st, h_st); if (DIAG == 0 && MODE == 1 && g2 == 0) *lp_st = lse_st; } } while (0)
    int ui = 0, ukvh, utile;
    bool have = att_unit(0, G, bid, ukvh, utile);
    AttU cu = att_decode(have ? ukvh : 0, have ? utile : 0, dsh);
    ATT_LOADS(cu);
    for (; have; ++ui) {
        const int kvh = cu.kvh, t0 = cu.t0, Ls = cu.Ls;
        const int h = kvh * 4 + hh;
        const int cu_rown = cu.rown;
        const int rowq = cu.rown + ((t0 + 32 * half + ql) << dsh);
        if (kvh != tb_kvh) {
            float gqm = 0.f, gkm = 0.f;
            for (int i = 0; i < 64; ++i) { gqm = fmaxf(gqm, fabsf(gq[i])); gkm = fmaxf(gkm, fabsf(gk[i])); }
            float sh[4];
#pragma unroll
            for (int hq = 0; hq < 4; ++hq) { float bm = -1e30f; for (int b = 0; b < 32; ++b) bm = fmaxf(bm, rel_table[b * 16 + kvh * 4 + hq]); sh[hq] = (8.0f * gqm * gkm + bm) * LOG2E; }
            if (tid < 4) Sh[tid] = tid == 0 ? sh[0] : tid == 1 ? sh[1] : tid == 2 ? sh[2] : sh[3];
            for (int e = tid; e < 16 * TBN; e += NWAVES * 64) {
                const int hq = e / (4 * TBN), b4 = (e / TBN) & 3, j = e % TBN, idx = j + 3 - b4, rel = idx - 31 - HW; float v = -1e30f;
                if (rel >= -HW && rel <= HW) { const int off = rel * (1 << dsh), n = off < 0 ? -off : off;
                    int b = n < 8 ? n : (n < 15 ? 8 : n < 27 ? 9 : n < 50 ? 10 : n < 91 ? 11 : n < 166 ? 12 : n < 305 ? 13 : n < 559 ? 14 : 15);
                    b += off > 0 ? 16 : 0; v = rel_table[b * 16 + kvh * 4 + hq] * LOG2E - (hq == 0 ? sh[0] : hq == 1 ? sh[1] : hq == 2 ? sh[2] : sh[3]); }
                Tb[e] = v; }
            tb_kvh = kvh;
        }
        if (DIAG == 3) { _Pragma("unroll") for (int p = 0; p < NPASS; ++p) asm volatile("" :: "v"(kraw[p])); _Pragma("unroll") for (int iv = 0; iv < NVI; ++iv) _Pragma("unroll") for (int jj = 0; jj < 4; ++jj) asm volatile("" :: "v"(vraw[iv][jj])); }
        if (DIAG != 3)
#pragma unroll
        for (int p = 0; p < NPASS; ++p) {
            const int kk = p * 64 + skk; float f[8]; float ss = 0.f;
#pragma unroll
            for (int j = 0; j < 8; ++j) { f[j] = bf2f(kraw[p][j]); ss += f[j] * f[j]; }
            ss += __shfl_xor(ss, 1); ss += __shfl_xor(ss, 2); ss += __shfl_xor(ss, 4);
            const float rs = __builtin_amdgcn_rsqf(ss * (1.0f / 64.0f) + EPS);
            u32x4 pk; pk.x = cvt_pk_bf16(f[0] * rs * gkr[0], f[1] * rs * gkr[1]); pk.y = cvt_pk_bf16(f[2] * rs * gkr[2], f[3] * rs * gkr[3]);
            pk.z = cvt_pk_bf16(f[4] * rs * gkr[4], f[5] * rs * gkr[5]); pk.w = cvt_pk_bf16(f[6] * rs * gkr[6], f[7] * rs * gkr[7]);
            *(LAS u32x4*)(lds + KS_OFF + kk * KST + sdc * 16) = pk;
        }
        if (DIAG != 3)
#pragma unroll
        for (int iv = 0; iv < NVI; ++iv) { const int it = tid + 512 * iv, kg = it >> 3;
            if (it < NVIT) {
#pragma unroll
                for (int j = 0; j < 8; ++j) { const s16x4 t4 = {vraw[iv][0][j], vraw[iv][1][j], vraw[iv][2][j], vraw[iv][3][j]};
                    *(LAS s16x4*)(lds + VT_OFF + (sdc * 8 + j) * VST + kg * 8) = t4; } } }
        __syncthreads();
        bf16x8 qf[4];
        {
            float ss = 0.f;
#pragma unroll
            for (int ks = 0; ks < 4; ++ks)
#pragma unroll
                for (int j = 0; j < 8; ++j) { const float f = bf2f(qr[ks][j]); ss += f * f; }
            ss += __shfl_xor(ss, 32);
            const float rs = __builtin_amdgcn_rsqf(ss * (1.0f / 64.0f) + EPS);
#pragma unroll
            for (int ks = 0; ks < 4; ++ks) { const f32x4 ga = *(const LAS f32x4*)(Gq + 16 * ks + 8 * g2), gb = *(const LAS f32x4*)(Gq + 16 * ks + 8 * g2 + 4); u32x4 pk;
                pk.x = cvt_pk_bf16(bf2f(qr[ks][0]) * rs * ga[0], bf2f(qr[ks][1]) * rs * ga[1]); pk.y = cvt_pk_bf16(bf2f(qr[ks][2]) * rs * ga[2], bf2f(qr[ks][3]) * rs * ga[3]);
                pk.z = cvt_pk_bf16(bf2f(qr[ks][4]) * rs * gb[0], bf2f(qr[ks][5]) * rs * gb[1]); pk.w = cvt_pk_bf16(bf2f(qr[ks][6]) * rs * gb[2], bf2f(qr[ks][7]) * rs * gb[3]);
                qf[ks] = __builtin_bit_cast(bf16x8, pk); }
        }
        f32x16 o0, o1; float lsum = 0.f;
        if (MODE == 2) { const float w0 = __builtin_amdgcn_exp2f(pl0 - Sh[hh]), w1 = __builtin_amdgcn_exp2f(pl1 - Sh[hh]);
#pragma unroll
            for (int it = 0; it < 4; ++it) *(LAS u32x4*)(ostw + (8 * it + (lane >> 3)) * 144 + 16 * (lane & 7)) = pra[it];
            asm volatile("" ::: "memory");
#pragma unroll
            for (int q4 = 0; q4 < 4; ++q4) { const s16x4 a0 = *(const LAS s16x4*)(ostw + ql * 144 + (8 * q4 + 4 * g2) * 2), a1 = *(const LAS s16x4*)(ostw + ql * 144 + (32 + 8 * q4 + 4 * g2) * 2);
#pragma unroll
                for (int j = 0; j < 4; ++j) { o0[4 * q4 + j] = w0 * bf2f(a0[j]); o1[4 * q4 + j] = w0 * bf2f(a1[j]); } }
            asm volatile("" ::: "memory");
#pragma unroll
            for (int it = 0; it < 4; ++it) *(LAS u32x4*)(ostw + (8 * it + (lane >> 3)) * 144 + 16 * (lane & 7)) = prb[it];
            asm volatile("" ::: "memory");
#pragma unroll
            for (int q4 = 0; q4 < 4; ++q4) { const s16x4 b0 = *(const LAS s16x4*)(ostw + ql * 144 + (8 * q4 + 4 * g2) * 2), b1 = *(const LAS s16x4*)(ostw + ql * 144 + (32 + 8 * q4 + 4 * g2) * 2);
#pragma unroll
                for (int j = 0; j < 4; ++j) { o0[4 * q4 + j] += w1 * bf2f(b0[j]); o1[4 * q4 + j] += w1 * bf2f(b1[j]); } }
            asm volatile("" ::: "memory");
            lsum = g2 == 0 ? w0 + w1 : 0.f; }
        else {
#pragma unroll
            for (int i = 0; i < 16; ++i) { o0[i] = 0.f; o1[i] = 0.f; } }
        if (DEFER) ATT_FLUSH();
        { int nk, nt; have = att_unit(ui + 1, G, bid, nk, nt); if (have) cu = att_decode(nk, nt, dsh); ATT_LOADS(cu); }
        const float mrun = Sh[hh];
        int c_lo = half, c_hi = half + HW / 16;
        { const int lo2 = (HW - t0 + 31) >> 5, hi2 = ((Ls + HW - t0) >> 5) - 1; c_lo = lo2 > c_lo ? lo2 : c_lo; c_hi = hi2 < c_hi ? hi2 : c_hi; }
        if (DIAG == 2 || DIAG == 3) c_hi = c_lo - 1;
        const LAS unsigned char* kbase = lds + KS_OFF + ql * KST + 16 * g2;
        const LAS float* tbase = Tb + (hh * 4 + (ql & 3)) * TBN + 28 - (ql & ~3) + 4 * g2 - 32 * half;
        const LAS unsigned char* vbase = lds + VT_OFF + ql * VST + 8 * g2;
        f32x16 sc;
        {
            bf16x8 ka[4]; f32x4 bz[4];
#pragma unroll
            for (int ks = 0; ks < 4; ++ks) ka[ks] = *(const LAS bf16x8*)(kbase + c_lo * 32 * KST + 32 * ks);
#pragma unroll
            for (int q4 = 0; q4 < 4; ++q4) bz[q4] = *(const LAS f32x4*)(tbase + 32 * c_lo + 8 * q4);
#pragma unroll
            for (int i = 0; i < 16; ++i) sc[i] = bz[i >> 2][i & 3];
#pragma unroll
            for (int ks = 0; ks < 4; ++ks) sc = __builtin_amdgcn_mfma_f32_32x32x16_bf16(ka[ks], qf[ks], sc, 0, 0, 0);
        }
        f32x2p ls2 = {0.f, 0.f};
        for (int c = c_lo; c <= c_hi; ++c) {
            const int cn = c < c_hi ? c + 1 : c;
            bf16x8 kn[4]; f32x4 bn[4]; s16x4 vf[2][4];
#pragma unroll
            for (int ks = 0; ks < 4; ++ks) kn[ks] = *(const LAS bf16x8*)(kbase + cn * 32 * KST + 32 * ks);
#pragma unroll
            for (int q4 = 0; q4 < 4; ++q4) bn[q4] = *(const LAS f32x4*)(tbase + 32 * cn + 8 * q4);
#pragma unroll
            for (int mt = 0; mt < 2; ++mt)
#pragma unroll
                for (int j = 0; j < 4; ++j) vf[mt][j] = *(const LAS s16x4*)(vbase + mt * 32 * VST + c * 64 + 16 * j);
            f32x16 sn;
#pragma unroll
            for (int i = 0; i < 16; ++i) sn[i] = bn[i >> 2][i & 3];
#pragma unroll
            for (int ks = 0; ks < 4; ++ks) { if (DIAG == 5) { sn[ks] += bf2f(kn[ks][0]) * bf2f(qf[ks][0]); } else sn = __builtin_amdgcn_mfma_f32_32x32x16_bf16(kn[ks], qf[ks], sn, 0, 0, 0); }
            float pr[16];
#pragma unroll
            for (int i = 0; i < 16; ++i) pr[i] = DIAG == 4 ? sc[i] * 1.0001f : __builtin_amdgcn_exp2f(sc[i]);
#pragma unroll
            for (int i = 0; i < 8; ++i) ls2 += (f32x2p){pr[2 * i], pr[2 * i + 1]};
            u32x4 pa, pb;
            pa.x = cvt_pk_bf16(pr[0], pr[1]); pa.y = cvt_pk_bf16(pr[2], pr[3]); pa.z = cvt_pk_bf16(pr[4], pr[5]); pa.w = cvt_pk_bf16(pr[6], pr[7]);
            pb.x = cvt_pk_bf16(pr[8], pr[9]); pb.y = cvt_pk_bf16(pr[10], pr[11]); pb.z = cvt_pk_bf16(pr[12], pr[13]); pb.w = cvt_pk_bf16(pr[14], pr[15]);
            const bf16x8 p0 = __builtin_bit_cast(bf16x8, pa), p1 = __builtin_bit_cast(bf16x8, pb);
            if (DIAG == 5) { o0[0] += bf2f(vf[0][0][0]) * bf2f(p0[0]); o1[0] += bf2f(vf[1][0][0]) * bf2f(p0[1]); o0[1] += bf2f(vf[0][2][0]) * bf2f(p1[0]); o1[1] += bf2f(vf[1][2][0]) * bf2f(p1[1]); o0[2] += bf2f(vf[0][1][0]) + bf2f(vf[0][3][0]) + bf2f(vf[1][1][0]) + bf2f(vf[1][3][0]); } else {
            o0 = __builtin_amdgcn_mfma_f32_32x32x16_bf16(__builtin_shufflevector(vf[0][0], vf[0][1], 0, 1, 2, 3, 4, 5, 6, 7), p0, o0, 0, 0, 0);
            o1 = __builtin_amdgcn_mfma_f32_32x32x16_bf16(__builtin_shufflevector(vf[1][0], vf[1][1], 0, 1, 2, 3, 4, 5, 6, 7), p0, o1, 0, 0, 0);
            o0 = __builtin_amdgcn_mfma_f32_32x32x16_bf16(__builtin_shufflevector(vf[0][2], vf[0][3], 0, 1, 2, 3, 4, 5, 6, 7), p1, o0, 0, 0, 0);
            o1 = __builtin_amdgcn_mfma_f32_32x32x16_bf16(__builtin_shufflevector(vf[1][2], vf[1][3], 0, 1, 2, 3, 4, 5, 6, 7), p1, o1, 0, 0, 0); }
            sc = sn;
        }
        lsum += ls2.x + ls2.y;
        lsum += __shfl_xor(lsum, 32);
        if (MODE == 0) lsum += __builtin_amdgcn_exp2f(sink[h] * LOG2E - mrun);
        const float f2 = 1.0f / lsum;
        if (MODE == 1) { lse_st = mrun + __builtin_amdgcn_logf(lsum); lp_st = LSEw + (size_t)rowq * 16 + h; if (!DEFER && DIAG == 0 && g2 == 0) *lp_st = lse_st; }
        bf16* op = O + (size_t)rowq * D + h * 64 + 4 * g2;
#pragma unroll
        for (int mt = 0; mt < 2; ++mt)
#pragma unroll
            for (int q4 = 0; q4 < 4; ++q4) {
                float v[4];
#pragma unroll
                for (int j = 0; j < 4; ++j) v[j] = (mt == 0 ? o0[4 * q4 + j] : o1[4 * q4 + j]) * f2;
                u32x2 o; o.x = cvt_pk_bf16(v[0], v[1]); o.y = cvt_pk_bf16(v[2], v[3]);
                if (LTR) *(LAS u32x2*)(ostw + ql * 144 + (mt * 32 + 8 * q4 + 4 * g2) * 2) = o;
                else { if (DIAG == 0) *(u32x2*)(op + mt * 32 + 8 * q4) = o; else asm volatile("" :: "v"(o)); }
            }
        if (LTR) { const int rb = cu_rown + ((t0 + 32 * half) << dsh);
            if (DEFER) { rb_st = rb; h_st = h; have_st = true; } else ATT_ROWS_OUT(rb, h); }
        __syncthreads();
    }
    if (DEFER) ATT_FLUSH();
#undef ATT_FLUSH
#undef ATT_ROWS_OUT
#undef ATT_LOADS
}


#define XB_TMO      128
#define XB_XCNT(j)  (256  + 64 * (j))
#define XB_XSUB(j)  (1280 + 64 * (j))
#define XB_XGEN(j)  (2304 + 64 * (j))
#define XB_TOP      3328
#define XB_TOPGEN   3392
#define XCD_BAR_WORDS 3456
#define XB_SPIN_CAP (1u << 18)

__device__ __forceinline__ unsigned xb_ld(unsigned* p)              { return __hip_atomic_load(p, __ATOMIC_RELAXED, __HIP_MEMORY_SCOPE_AGENT); }
__device__ __forceinline__ unsigned xb_add(unsigned* p, unsigned v) { return __hip_atomic_fetch_add(p, v, __ATOMIC_RELAXED, __HIP_MEMORY_SCOPE_AGENT); }
__device__ __forceinline__ unsigned xb_xcc_id() { return (unsigned)__builtin_amdgcn_s_getreg((3 << 11) | 20) & 0xFu; }
#define XB_SPIN(cond, bar) do { unsigned _sp = 0; while (cond) { __builtin_amdgcn_s_sleep(1); \
    if ((++_sp & 255u) == 0u) { if (xb_ld(&(bar)[XB_TMO])) break; if (_sp > XB_SPIN_CAP) { atomicAdd(&(bar)[XB_TMO], 1u); break; } } } } while (0)

struct XcdBarrier {
    unsigned* bar; unsigned x;
    volatile LAS unsigned* st;
};

__device__ __forceinline__ XcdBarrier xcd_barrier_post(unsigned* bar, volatile LAS unsigned* st) {
    XcdBarrier b; b.bar = bar; b.x = xb_xcc_id(); b.st = st;
    if (threadIdx.x == 0) (void)xb_add(&bar[XB_XCNT(b.x)], 1u);
    return b;
}
__device__ __forceinline__ void xcd_barrier_complete(unsigned* bar, unsigned x, unsigned& nloc, unsigned& nx) {
    const unsigned G = gridDim.x * gridDim.y * gridDim.z;
    unsigned sum, cnt, mine, sp = 0u;
    for (;;) {
        sum = 0u; cnt = 0u; mine = 0u;
#pragma unroll
        for (unsigned j = 0; j < 16; ++j) { const unsigned c = xb_ld(&bar[XB_XCNT(j)]); sum += c; cnt += (c > 0u) ? 1u : 0u; mine = (j == x) ? c : mine; }
        if (sum == G) break;
        __builtin_amdgcn_s_sleep(1);
        if ((++sp & 255u) == 0u) { if (xb_ld(&bar[XB_TMO])) break; if (sp > XB_SPIN_CAP) { atomicAdd(&bar[XB_TMO], 1u); break; } }
    }
    nloc = mine > 0u ? mine : 1u; nx = cnt > 0u ? cnt : 1u;
}

__device__ __forceinline__ void xcd_barrier(const XcdBarrier& b) {
    asm volatile("s_waitcnt vmcnt(0)" ::: "memory");
    __syncthreads();
    if (threadIdx.x == 0) {
        unsigned* bar = b.bar;
        __builtin_amdgcn_s_waitcnt(0);
        unsigned nloc = b.st[0], nx = b.st[1];
        if (nloc == 0u) { xcd_barrier_complete(bar, b.x, nloc, nx); b.st[0] = nloc; b.st[1] = nx; }
        const unsigned old = xb_add(&bar[XB_XSUB(b.x)], 1u);
        const unsigned gen = old / nloc;
        if (old + 1u == (gen + 1u) * nloc) {
            __builtin_amdgcn_fence(__ATOMIC_RELEASE, "agent");
            asm volatile("s_waitcnt vmcnt(0)" ::: "memory");
            const unsigned og = xb_add(&bar[XB_TOP], 1u);
            const unsigned tg = og / nx;
            if (og + 1u == (tg + 1u) * nx) xb_add(&bar[XB_TOPGEN], 1u);
            else XB_SPIN(xb_ld(&bar[XB_TOPGEN]) == tg, bar);
            __builtin_amdgcn_fence(__ATOMIC_ACQUIRE, "agent");
            xb_add(&bar[XB_XGEN(b.x)], 1u);
            asm volatile("s_waitcnt vmcnt(0)" ::: "memory");
        } else {
            XB_SPIN(xb_ld(&bar[XB_XGEN(b.x)]) == gen, bar);
            __builtin_amdgcn_fence(__ATOMIC_ACQUIRE, "agent");
            asm volatile("s_waitcnt vmcnt(0)" ::: "memory");
        }
    }
    __syncthreads();
}


__global__ void __launch_bounds__(NWAVES * 64, 2) fwd_megakernel(Args a) {
    extern __shared__ __attribute__((aligned(16))) unsigned char lds_raw[];
    LAS unsigned char* lds = (LAS unsigned char*)lds_raw;
    cg::grid_group grid = cg::this_grid();
    const int G = gridDim.x, bid = blockIdx.x;
    unsigned char* ws = a.ws;
    bf16* H = (bf16*)(ws + WS_H); bf16* QKV = (bf16*)(ws + WS_QKV); bf16* O0 = (bf16*)(ws + WS_O0); bf16* O1 = (bf16*)(ws + WS_O1); bf16* ACT = (bf16*)(ws + WS_ACT);
    float* LSE0 = (float*)(ws + WS_LSE); float* LSE1 = LSE0 + (size_t)M * 16;
    const float* xin0 = a.in[0]; const float* xin1 = a.in[1]; float* out = a.out;
    float* RSS = (float*)(ws + WS_RSS);

    volatile LAS unsigned* bst = (volatile LAS unsigned*)(lds + LDS_BYTES - 64);
    if (threadIdx.x < 4) bst[threadIdx.x] = 0u;
    __syncthreads();
    const XcdBarrier xbar = xcd_barrier_post((unsigned*)(ws + WS_CTL), bst);
    for (int ph = a.ph_lo, rep = 0; ph < a.ph_hi;) {
        int tid = threadIdx.x; asm volatile("" : "+v"(tid));
        const int lane = tid & 63, wave = __builtin_amdgcn_readfirstlane(tid >> 6), gw = bid * NWAVES + wave, NGW = G * NWAVES;
        if (ph == 0) { prologue_weights(a, lds, gw, NGW, wave, lane); norm_phase(xin0, xin1, a.in[3], H, gw, NGW, lane); }
        else if (ph == 4 || ph == 7 || ph == 15) {
#if PROBE_SYNCS
            if (ph == 4) for (int k = 0; k < PROBE_SYNCS; ++k) grid.sync();
#endif
            ++ph; continue; }
        else if (ph == 1 || ph == 8 || ph == 10 || ph == 12) {
            const bf16* Bt = ph == 1 ? (const bf16*)(ws + WS_WQKVA) : (const bf16*)(ws + WS_WQKVB) + (size_t)((ph - 8) >> 1) * NQKV * D;
            pg8::Gemm g{H, Bt, M, NQKV, D}; pg8::StaticOrder S; S.init(M, NQKV, G, bid);
            pg8::EpiBf16 E{(PROBE_NOSTORE == 2 && rep >= 1) ? ACT + (size_t)M * NQKV : QKV, NQKV, ph == 10 ? 2 : ph == 12 ? 4 : 0, ROWS_P, (PROBE_NOSTORE && rep >= 1) ? PROBE_NOSTORE : 0, ph == 1 ? nullptr : RSS + (size_t)M * 16};
            pg8::gemm_phase<pg8::EpiBf16, pg8::StaticOrder, true, true>(lds, g, S, E, tid, STAGGER_BF16);
        }
        else if (ph == 2) attn_phase<128, 0>(lds, QKV, O0, nullptr, nullptr, nullptr, nullptr, 0, a.in[6], a.in[7], a.in[8], a.in[2], G, bid, tid);
        else if (ph == 9 || ph == 11) {
            const int gi = (ph - 9) >> 1;
#if PROBE_DIAG
            if (rep >= 1) attn_phase<64, 1, PROBE_DIAG>(lds, QKV, gi ? O1 : O0, nullptr, gi ? LSE1 : LSE0, nullptr, nullptr, 2 * gi, a.in[11] + 64 * gi, a.in[12] + 64 * gi, nullptr, a.in[2], G, bid, tid); else
#endif
            attn_phase<64, 1>(lds, QKV, gi ? O1 : O0, nullptr, gi ? LSE1 : LSE0, nullptr, nullptr, 2 * gi, a.in[11] + 64 * gi, a.in[12] + 64 * gi, nullptr, a.in[2], G, bid, tid);
        }
        else if (ph == 13) attn_phase<64, 2>(lds, QKV, O0, O1, nullptr, LSE0, LSE1, 4, a.in[11] + 128, a.in[12] + 128, nullptr, a.in[2], G, bid, tid);
        else if (ph == 3 || ph == 14 || ph == 6 || ph == 17) {
            const bool isdown = (ph == 6 || ph == 17);
            const bf16* A = isdown ? ACT : O0;
            const bf16* Bt = ph == 3 ? (const bf16*)(ws + WS_WOA) : ph == 14 ? (const bf16*)(ws + WS_WOB) : (const bf16*)(ws + WS_WDN) + (size_t)(ph == 17 ? 1 : 0) * D * DFF;
            pg8::Gemm g{A, Bt, M, D, isdown ? DFF : D}; pg8::StaticOrder S; S.init(M, D, G, bid);
            const int rk = ph == 3 ? 0 : ph == 6 ? 1 : 2;
            pg8::EpiResid E{xin0, xin1, ROWS_P, ph == 3 ? 1 : 0, ph == 17 ? 1 : 0, H, out, D, RSS + (size_t)rk * M * 16};
            pg8::gemm_phase<pg8::EpiResid, pg8::StaticOrder, true, true>(lds, g, S, E, tid, STAGGER_RESID);
        }
        else {
            const bf16* Bt = (const bf16*)(ws + WS_WGU) + (size_t)(ph == 16 ? 1 : 0) * 2 * DFF * D;
            const int Mrun = (PROBE_MSPLIT && rep >= 1) ? PROBE_MSPLIT : M;
            pg8::Gemm g{H, Bt, Mrun, 2 * DFF, D}; pg8::StaticOrder S; S.init(Mrun, 2 * DFF, G, bid);
            pg8::EpiSwiglu E{ACT, DFF, RSS + (size_t)(ph == 16 ? 2 : 0) * M * 16};
            pg8::gemm_phase<pg8::EpiSwiglu, pg8::StaticOrder, true, true>(lds, g, S, E, tid, STAGGER_BF16);
        }
        const bool again = ((REPEAT_MASK >> ph) & 1) && rep < REPEAT_N;
        if (PROBE_NOBAR && again) __syncthreads();
        else if (ph + 1 < a.ph_hi || again) { if (a.ph_lo < 0) grid.sync(); else xcd_barrier(xbar); }
        if (again) ++rep; else { rep = 0; ++ph; }
    }
}

extern "C" void kernel_launch(void* const* d_in, const int* in_sizes, int n_in, void* d_out, int out_size, void* d_ws, size_t ws_size, hipStream_t stream) {
    static int grid = 0;
    if (grid == 0) {
        if (n_in != 16 || out_size != M * D || ws_size < WS_END) { fprintf(stderr, "kernel_launch: unexpected shapes (n_in %d out %d ws %zu)\n", n_in, out_size, ws_size); grid = -1; return; }
        int dev = 0, cus = 0, per_cu = 0;
        hipGetDevice(&dev); hipDeviceGetAttribute(&cus, hipDeviceAttributeMultiprocessorCount, dev);
        if (hipFuncSetAttribute((const void*)fwd_megakernel, hipFuncAttributeMaxDynamicSharedMemorySize, LDS_BYTES) != hipSuccess) { fprintf(stderr, "kernel_launch: hipFuncSetAttribute failed\n"); grid = -1; return; }
        hipOccupancyMaxActiveBlocksPerMultiprocessor(&per_cu, (const void*)fwd_megakernel, NWAVES * 64, LDS_BYTES);
        if (per_cu < 1) { fprintf(stderr, "kernel_launch: occupancy query says %d blocks/CU\n", per_cu); per_cu = 1; }
        (void)hipGetLastError();
        grid = cus;
    }
    if (grid < 0) return;
    if (hipMemsetAsync((char*)d_ws + WS_CTL, 0, CTL_ZERO_BYTES, stream) != hipSuccess) { fprintf(stderr, "kernel_launch: hipMemsetAsync failed\n"); return; }
    Args a{};
    for (int i = 0; i < 16; ++i) a.in[i] = (const float*)d_in[i];
    a.out = (float*)d_out; a.ws = (unsigned char*)d_ws;
#if MK_SINGLE
    a.ph_lo = 0; a.ph_hi = NPHASES;
    void* kargs[] = {&a};
    hipError_t e = hipLaunchCooperativeKernel((const void*)fwd_megakernel, dim3(grid), dim3(NWAVES * 64), kargs, LDS_BYTES, stream);
    if (e != hipSuccess) fprintf(stderr, "kernel_launch: cooperative launch failed: %s (grid %d)\n", hipGetErrorString(e), grid);
#else
    for (int ph = 0; ph < NPHASES; ++ph) { a.ph_lo = ph; a.ph_hi = ph + 1; hipLaunchKernelGGL(fwd_megakernel, dim3(grid), dim3(NWAVES * 64), LDS_BYTES, stream, a); }
#endif
}
```

```cpp
#include <hip/hip_runtime.h>
#include <hip/hip_cooperative_groups.h>
#include <cstdio>
#include <cstdint>
namespace cg = cooperative_groups;
namespace pg8 {
#define PG8_LAS __attribute__((address_space(3)))
typedef unsigned short bf16_t;
typedef short bf16x8 __attribute__((ext_vector_type(8)));
typedef float f32x4 __attribute__((ext_vector_type(4)));
typedef unsigned u32x4 __attribute__((ext_vector_type(4)));
constexpr int BM = 256, BK = 64, HALF = 128, HTB = HALF * BK * 2  , STAGE_BYTES = 8 * HTB, NXCD = 8, WGM = 8;

__host__ __device__ __forceinline__ int lds_byte(int r, int c) { const int st = (r >> 4) * 2 + (c >> 5), rr = r & 15, cc = c & 31, ob = rr * 64 + cc * 2; return st * 1024 + (ob ^ (((ob >> 9) & 1) << 5)); }
__host__ __device__ __forceinline__ void stage_rc(int b, int& R, int& C) { const int st = b / 1024, sb = b % 1024, swz = sb ^ (((sb >> 9) & 1) << 5); R = (st >> 1) * 16 + swz / 64; C = (st & 1) * 32 + (swz % 64) / 2; }
__host__ __device__ __forceinline__ int perm32(int rho) { const int n = rho >> 4, i = rho & 15; return 8 * (i >> 2) + 4 * n + (i & 3); }

struct Unit { int pm, pn; };
struct Gemm { const bf16_t* A; const bf16_t* Bt; int M, N, K; };

struct StaticOrder {
    int nM, nN, nwg, G, c;
    __host__ __device__ void init(int M, int N, int G_, int c_) { nM = M / BM; nN = N / BM; nwg = nM * nN; G = G_; c = c_; }
    __host__ __device__ bool next(int i, Unit& u) const {
        const long L = (long)i * G + c; if (L >= nwg) return false;
        int wgid = (int)L; { const int q = nwg / NXCD, r = nwg % NXCD, xcd = wgid % NXCD, off = wgid / NXCD; wgid = (xcd < r ? xcd * (q + 1) : r * (q + 1) + (xcd - r) * q) + off; }
        const int nig = WGM * nN, gid = wgid / nig, fm = gid * WGM, gsz = (nM - fm) < WGM ? (nM - fm) : WGM;
        u.pm = fm + ((wgid % nig) % gsz); u.pn = (wgid % nig) / gsz; return true;
    }
    __device__ __forceinline__ void a_ready(const Unit&) const {}
    __device__ __forceinline__ void done(const Unit&) const {}
};

typedef __bf16 bf16x2_hw __attribute__((ext_vector_type(2)));
typedef float f32x2_hw __attribute__((ext_vector_type(2)));
__device__ __forceinline__ unsigned cvt_pk_bf16(float lo, float hi) { f32x2_hw v = {lo, hi}; bf16x2_hw b = __builtin_convertvector(v, bf16x2_hw); return __builtin_bit_cast(unsigned, b); }

struct EpiBf16 {
    static constexpr bool PERM = true, AFTER_DRAIN = false;
    bf16_t* O; int ldc; int dsh; int split;
    int nostore;
    const float* rss;
    __device__ __forceinline__ void operator()(const f32x4 (&acc)[2][2][4][2], const Unit& u, int wr, int wc, int fr, int fq) const {
        const int row0 = u.pm * BM + wr * 64 + fr; const int col0 = u.pn * BM + wc * 64 + 8 * fq;
        const int lsh = (u.pm * BM < split) ? 11 : 13, lmask = (1 << lsh) - 1;
        float rstd[2][4];
        if (rss) { f32x4 pv[2][4];
#pragma unroll
            for (int ai = 0; ai < 2; ++ai)
#pragma unroll
                for (int m = 0; m < 4; ++m) pv[ai][m] = *(const f32x4*)(rss + (size_t)(row0 + ai * HALF + m * 16) * 16 + 4 * fq);
#pragma unroll
            for (int ai = 0; ai < 2; ++ai)
#pragma unroll
                for (int m = 0; m < 4; ++m) { float t = (pv[ai][m][0] + pv[ai][m][1]) + (pv[ai][m][2] + pv[ai][m][3]); t += __shfl_xor(t, 16); t += __shfl_xor(t, 32); rstd[ai][m] = __builtin_amdgcn_rsqf(t * (1.0f / 1024.0f) + 1e-6f); }
        } else {
#pragma unroll
            for (int ai = 0; ai < 2; ++ai)
#pragma unroll
                for (int m = 0; m < 4; ++m) rstd[ai][m] = 1.0f; }
#pragma unroll
        for (int ai = 0; ai < 2; ++ai)
#pragma unroll
            for (int m = 0; m < 4; ++m) { const int row = row0 + ai * HALF + m * 16, rs = row - split, pos = rs & lmask;
                const int orow = dsh ? (row - pos) + ((pos & ((1 << dsh) - 1)) << (lsh - dsh)) + (pos >> dsh) : row;
                bf16_t* rowp = O + (size_t)orow * ldc + col0;
#pragma unroll
                for (int bj = 0; bj < 2; ++bj) { const f32x4 v0 = acc[ai][bj][m][0] * rstd[ai][m], v1 = acc[ai][bj][m][1] * rstd[ai][m];
                    u32x4 w; w.x = cvt_pk_bf16(v0[0], v0[1]); w.y = cvt_pk_bf16(v0[2], v0[3]); w.z = cvt_pk_bf16(v1[0], v1[1]); w.w = cvt_pk_bf16(v1[2], v1[3]);
                    if (!nostore) *(u32x4*)(rowp + bj * 32) = w;
                    else if (nostore == 2) { const int lane_ = fr + 16 * fq, wv_ = wr * 4 + wc; *(u32x4*)(O + (size_t)(u.pm * 6 + u.pn) * 65536 + wv_ * 8192 + ((ai * 4 + m) * 2 + bj) * 512 + lane_ * 8) = w; }
                    else asm volatile("" :: "v"(w)); } }
    }
};
struct EpiSwiglu {
    static constexpr bool PERM = true, AFTER_DRAIN = false;
    bf16_t* O; int ldc; const float* rss;
    __device__ __forceinline__ static float act(float g, float up) { return g * up * __builtin_amdgcn_rcpf(1.0f + __builtin_amdgcn_exp2f(-1.44269504089f * g)); }
    __device__ __forceinline__ void operator()(const f32x4 (&acc)[2][2][4][2], const Unit& u, int wr, int wc, int fr, int fq) const {
        const int row0 = u.pm * BM + wr * 64 + fr; const int col0 = u.pn * HALF + wc * 32 + 8 * fq;
        float rstd[2][4];
        { f32x4 pv[2][4];
#pragma unroll
            for (int ai = 0; ai < 2; ++ai)
#pragma unroll
                for (int m = 0; m < 4; ++m) pv[ai][m] = *(const f32x4*)(rss + (size_t)(row0 + ai * HALF + m * 16) * 16 + 4 * fq);
#pragma unroll
            for (int ai = 0; ai < 2; ++ai)
#pragma unroll
                for (int m = 0; m < 4; ++m) { float t = (pv[ai][m][0] + pv[ai][m][1]) + (pv[ai][m][2] + pv[ai][m][3]); t += __shfl_xor(t, 16); t += __shfl_xor(t, 32); rstd[ai][m] = __builtin_amdgcn_rsqf(t * (1.0f / 1024.0f) + 1e-6f); } }
#pragma unroll
        for (int ai = 0; ai < 2; ++ai)
#pragma unroll
            for (int m = 0; m < 4; ++m) { const int row = row0 + ai * HALF + m * 16; bf16_t* rowp = O + (size_t)row * ldc + col0;
                const float r = rstd[ai][m];
                const f32x4 g0 = acc[ai][0][m][0] * r, g1 = acc[ai][0][m][1] * r, u0 = acc[ai][1][m][0] * r, u1 = acc[ai][1][m][1] * r;
                u32x4 w; w.x = cvt_pk_bf16(act(g0[0], u0[0]), act(g0[1], u0[1])); w.y = cvt_pk_bf16(act(g0[2], u0[2]), act(g0[3], u0[3]));
                w.z = cvt_pk_bf16(act(g1[0], u1[0]), act(g1[1], u1[1])); w.w = cvt_pk_bf16(act(g1[2], u1[2]), act(g1[3], u1[3]));
                *(u32x4*)rowp = w; }
    }
};
struct EpiResid {
    static constexpr bool PERM = true, AFTER_DRAIN = false;
    const float* base0; const float* base1; int split; int base_f32; int out_f32;
    bf16_t* X; float* out; int ldc; float* rss;
    __device__ __forceinline__ void operator()(const f32x4 (&acc)[2][2][4][2], const Unit& u, int wr, int wc, int fr, int fq) const {
        const int row0 = u.pm * BM + wr * 64 + fr; const int col0 = u.pn * BM + wc * 64 + 8 * fq;
        const float* bb = (u.pm * BM < split) ? base0 : base1 - (size_t)split * ldc;
#define RES_ROW(ai, m, B00, B01, B10, B11) do { const int row = row0 + (ai) * HALF + (m) * 16; const size_t off = (size_t)row * ldc + col0; float ssq = 0.f; \
            _Pragma("unroll") for (int bj = 0; bj < 2; ++bj) { \
                const f32x4 v0 = (bj ? (B10) : (B00)) + acc[ai][bj][m][0], v1 = (bj ? (B11) : (B01)) + acc[ai][bj][m][1]; \
                if (out_f32) { *(f32x4*)(out + off + bj * 32) = v0; *(f32x4*)(out + off + bj * 32 + 4) = v1; } \
                else { u32x4 w; w.x = cvt_pk_bf16(v0[0], v0[1]); w.y = cvt_pk_bf16(v0[2], v0[3]); w.z = cvt_pk_bf16(v1[0], v1[1]); w.w = cvt_pk_bf16(v1[2], v1[3]); \
                    *(u32x4*)(X + off + bj * 32) = w; \
                    ssq += (v0[0] * v0[0] + v0[1] * v0[1]) + (v0[2] * v0[2] + v0[3] * v0[3]) + (v1[0] * v1[0] + v1[1] * v1[1]) + (v1[2] * v1[2] + v1[3] * v1[3]); } } \
            if (!out_f32) { ssq += __shfl_xor(ssq, 16); ssq += __shfl_xor(ssq, 32); if (fq == 0) rss[(size_t)row * 16 + u.pn * 4 + wc] = ssq; } } while (0)
#define BF_LO(w) __builtin_bit_cast(float, (w) << 16)
#define BF_HI(w) __builtin_bit_cast(float, (w) & 0xffff0000u)
        if (base_f32) {
            f32x4 bq[2][2][2][2];
#define RES_LOAD(buf, t) do { _Pragma("unroll") for (int r_ = 0; r_ < 2; ++r_) { const size_t off_ = (size_t)(row0 + ((t) >> 1) * HALF + (2 * ((t) & 1) + r_) * 16) * ldc + col0; \
                _Pragma("unroll") for (int bj = 0; bj < 2; ++bj) { bq[buf][r_][bj][0] = *(const f32x4*)(bb + off_ + bj * 32); bq[buf][r_][bj][1] = *(const f32x4*)(bb + off_ + bj * 32 + 4); } } } while (0)
            RES_LOAD(0, 0);
#pragma unroll
            for (int t = 0; t < 4; ++t) {
                if (t + 1 < 4) { if ((t & 1) == 0) RES_LOAD(1, t + 1); else RES_LOAD(0, t + 1); }
#pragma unroll
                for (int r_ = 0; r_ < 2; ++r_) RES_ROW(t >> 1, 2 * (t & 1) + r_, bq[t & 1][r_][0][0], bq[t & 1][r_][0][1], bq[t & 1][r_][1][0], bq[t & 1][r_][1][1]);
            }
#undef RES_LOAD
        } else {
            u32x4 raw[2][4][2];
#define RAW_LOAD(ai, m) do { _Pragma("unroll") for (int bj = 0; bj < 2; ++bj) raw[ai][m][bj] = *(const u32x4*)(X + (size_t)(row0 + (ai) * HALF + (m) * 16) * ldc + col0 + bj * 32); } while (0)
#define RAW_ROW(ai, m) do { const u32x4 w0 = raw[ai][m][0], w1 = raw[ai][m][1]; \
                RES_ROW(ai, m, ((f32x4){BF_LO(w0.x), BF_HI(w0.x), BF_LO(w0.y), BF_HI(w0.y)}), ((f32x4){BF_LO(w0.z), BF_HI(w0.z), BF_LO(w0.w), BF_HI(w0.w)}), \
                               ((f32x4){BF_LO(w1.x), BF_HI(w1.x), BF_LO(w1.y), BF_HI(w1.y)}), ((f32x4){BF_LO(w1.z), BF_HI(w1.z), BF_LO(w1.w), BF_HI(w1.w)})); } while (0)
            RAW_LOAD(0, 0); RAW_LOAD(0, 1); RAW_LOAD(0, 2); RAW_LOAD(0, 3);
            RAW_LOAD(1, 0); RAW_LOAD(1, 1);
            RAW_ROW(0, 0); RAW_ROW(0, 1);
            RAW_LOAD(1, 2); RAW_LOAD(1, 3);
            RAW_ROW(0, 2); RAW_ROW(0, 3); RAW_ROW(1, 0); RAW_ROW(1, 1); RAW_ROW(1, 2); RAW_ROW(1, 3);
#undef RAW_LOAD
#undef RAW_ROW
        }
#undef BF_LO
#undef BF_HI
#undef RES_ROW
    }
};


template <class Epi, class Sched, bool ALIGN_EPI = false, bool SP2 = false>
__device__ __forceinline__ void gemm_phase(PG8_LAS unsigned char* lds, const Gemm g, const Sched& S, const Epi& E, const int tid, const int stagger_ticks) {
    { const unsigned grp = blockIdx.x & 7u;     if (grp && stagger_ticks > 0) { const unsigned long long t0_ = __builtin_amdgcn_s_memrealtime(), want_ = (unsigned long long)(grp * (unsigned)stagger_ticks);
        while (__builtin_amdgcn_s_memrealtime() - t0_ < want_) __builtin_amdgcn_s_sleep(8); } }
    const int wid = __builtin_amdgcn_readfirstlane(tid >> 6), lane = tid & 63, wr = wid >> 2, wc = wid & 3, fr = lane & 15, fq = lane >> 4;
    const int K = g.K, nt = K / BK;
    unsigned voffA[2], voffB[2];
#pragma unroll
    for (int i = 0; i < 2; ++i) { int R, C; stage_rc(tid * 16 + i * 8192, R, C); const int Rb = Epi::PERM ? ((R & ~31) + perm32(R & 31)) : R;
        voffA[i] = (unsigned)(R * K + C) * 2u; voffB[i] = (unsigned)(Rb * K + C) * 2u; }
    const size_t kstep = (size_t)(BK * 2);
    const size_t hstep = (size_t)HALF * K * 2;
    const size_t tstep = 2 * hstep;
    const unsigned ldsw = (unsigned)wid * 1024u;
    const int aoff = lds_byte(wr * 64 + fr, fq * 8), boff = lds_byte(wc * 32 + fr, fq * 8);
#define PG8_SA(b, h) (((b) * 2 + (h)) * HTB)
#define PG8_SB(b, h) ((4 + (b) * 2 + (h)) * HTB)
#define PG8_STAGE(bufoff, gbase, voff) do { _Pragma("unroll") for (int _i = 0; _i < 2; ++_i) \
        __builtin_amdgcn_global_load_lds((const unsigned*)((const char*)(gbase) + (voff)[_i]), (PG8_LAS unsigned*)(lds + (bufoff) + ldsw + _i * 8192), 16, 0, 0); } while (0)
#define PG8_LDA(dst, b, h) do { _Pragma("unroll") for (int m = 0; m < 4; ++m) _Pragma("unroll") for (int k = 0; k < 2; ++k) dst[m][k] = *(const PG8_LAS bf16x8*)(lds + PG8_SA(b, h) + aoff + m * 2048 + k * 1024); } while (0)
#define PG8_LDB(dst, b, h) do { _Pragma("unroll") for (int n = 0; n < 2; ++n) _Pragma("unroll") for (int k = 0; k < 2; ++k) dst[n][k] = *(const PG8_LAS bf16x8*)(lds + PG8_SB(b, h) + boff + n * 2048 + k * 1024); } while (0)
#define PG8_MMA(ai, bj, At, Bt) do { __builtin_amdgcn_s_setprio(1); _Pragma("unroll") for (int m = 0; m < 4; ++m) _Pragma("unroll") for (int n = 0; n < 2; ++n) _Pragma("unroll") for (int k = 0; k < 2; ++k) \
        acc[ai][bj][m][n] = __builtin_amdgcn_mfma_f32_16x16x32_bf16(Bt[n][k], At[m][k], acc[ai][bj][m][n], 0, 0, 0); __builtin_amdgcn_s_setprio(0); } while (0)
#define PG8_WAIT_V(n) asm volatile("s_waitcnt vmcnt(" #n ")" ::: "memory")
#define PG8_WAIT_L(n) asm volatile("s_waitcnt lgkmcnt(" #n ")" ::: "memory")
#define PG8_BAR __builtin_amdgcn_s_barrier()
#define PG8_SCHED __builtin_amdgcn_sched_barrier(0)
    Unit cur, nxt; int ui = 0;
    if (!S.next(0, cur)) return;
    f32x4 acc[2][2][4][2];
#pragma unroll
    for (int a = 0; a < 2; ++a)
#pragma unroll
        for (int b = 0; b < 2; ++b)
#pragma unroll
            for (int m = 0; m < 4; ++m)
#pragma unroll
                for (int n = 0; n < 2; ++n) acc[a][b][m][n] = (f32x4){0.f, 0.f, 0.f, 0.f};
    bf16x8 At[4][2], B0[2][2], B1[2][2];
    const char* cA = (const char*)g.A + (size_t)cur.pm * tstep; const char* cB = (const char*)g.Bt + (size_t)cur.pn * tstep;
    S.a_ready(cur);
    if constexpr (SP2) {
        PG8_STAGE(PG8_SB(0, 0), cB, voffB); PG8_STAGE(PG8_SB(0, 1), cB + hstep, voffB); PG8_STAGE(PG8_SA(0, 0), cA, voffA); PG8_STAGE(PG8_SA(0, 1), cA + hstep, voffA);
        if (wr == 1) PG8_BAR;
        PG8_WAIT_V(2); PG8_BAR;
        PG8_STAGE(PG8_SB(1, 0), cB + kstep, voffB); PG8_STAGE(PG8_SA(1, 0), cA + kstep, voffA); PG8_STAGE(PG8_SB(1, 1), cB + hstep + kstep, voffB);
        PG8_WAIT_V(6); PG8_BAR;
    } else {
        PG8_STAGE(PG8_SB(0, 0), cB, voffB); PG8_STAGE(PG8_SA(0, 0), cA, voffA); PG8_STAGE(PG8_SB(0, 1), cB + hstep, voffB); PG8_STAGE(PG8_SA(0, 1), cA + hstep, voffA);
        if (wr == 1) PG8_BAR;
        PG8_WAIT_V(4); PG8_BAR;
        PG8_STAGE(PG8_SB(1, 0), cB + kstep, voffB); PG8_STAGE(PG8_SA(1, 0), cA + kstep, voffA); PG8_STAGE(PG8_SB(1, 1), cB + hstep + kstep, voffB);
        PG8_WAIT_V(6); PG8_BAR;
    }
    for (;;) {
        const bool has_next = S.next(ui + 1, nxt);
        const char* nA = has_next ? (const char*)g.A + (size_t)nxt.pm * tstep : cA; const char* nB = has_next ? (const char*)g.Bt + (size_t)nxt.pn * tstep : cB;
        for (int t = 0; t < nt; t += 2) {
            const bool last = (t == nt - 2);
            const char* a1 = cA + (size_t)(t + 1) * kstep;
            const char* a2 = last ? nA : cA + (size_t)(t + 2) * kstep; const char* b2 = last ? nB : cB + (size_t)(t + 2) * kstep;
            const char* a3 = a2 + kstep; const char* b3 = b2 + kstep;
            if (last && has_next) S.a_ready(nxt);
            if constexpr (SP2) {
            PG8_LDB(B0, 0, 0); PG8_LDB(B1, 0, 1); PG8_SCHED; PG8_LDA(At, 0, 0); PG8_STAGE(PG8_SA(1, 1), a1 + hstep, voffA);
            PG8_WAIT_V(8); PG8_WAIT_L(0); PG8_BAR; PG8_MMA(0, 0, At, B0); PG8_MMA(0, 1, At, B1); PG8_BAR; PG8_SCHED;
            PG8_LDA(At, 0, 1); PG8_STAGE(PG8_SB(0, 0), b2, voffB); PG8_STAGE(PG8_SB(0, 1), b2 + hstep, voffB); PG8_STAGE(PG8_SA(0, 0), a2, voffA);
            PG8_WAIT_V(8); PG8_WAIT_L(0); PG8_BAR; PG8_MMA(1, 0, At, B0); PG8_MMA(1, 1, At, B1); PG8_BAR; PG8_SCHED;
            PG8_LDB(B0, 1, 0); PG8_LDB(B1, 1, 1); PG8_SCHED; PG8_LDA(At, 1, 0); PG8_STAGE(PG8_SA(0, 1), a2 + hstep, voffA);
            PG8_WAIT_V(8); PG8_WAIT_L(0); PG8_BAR; PG8_MMA(0, 0, At, B0); PG8_MMA(0, 1, At, B1); PG8_BAR; PG8_SCHED;
            PG8_LDA(At, 1, 1); PG8_STAGE(PG8_SB(1, 0), b3, voffB); PG8_STAGE(PG8_SB(1, 1), b3 + hstep, voffB); PG8_STAGE(PG8_SA(1, 0), a3, voffA);
            PG8_WAIT_V(8); PG8_WAIT_L(0); PG8_BAR; PG8_MMA(1, 0, At, B0); PG8_MMA(1, 1, At, B1); PG8_BAR; PG8_SCHED;
            } else {
            PG8_LDB(B0, 0, 0); PG8_SCHED; PG8_LDA(At, 0, 0); PG8_STAGE(PG8_SA(1, 1), a1 + hstep, voffA);
            PG8_WAIT_L(8); PG8_BAR; PG8_WAIT_L(0); PG8_MMA(0, 0, At, B0); PG8_BAR; PG8_SCHED;
            PG8_LDB(B1, 0, 1); PG8_STAGE(PG8_SB(0, 0), b2, voffB);
            PG8_BAR; PG8_WAIT_L(0); PG8_MMA(0, 1, At, B1); PG8_BAR;
            PG8_LDA(At, 0, 1); PG8_STAGE(PG8_SA(0, 0), a2, voffA);
            PG8_BAR; PG8_WAIT_L(0); PG8_MMA(1, 0, At, B0); PG8_BAR; PG8_SCHED;
            PG8_STAGE(PG8_SB(0, 1), b2 + hstep, voffB);
            PG8_WAIT_V(6); PG8_BAR; PG8_MMA(1, 1, At, B1); PG8_BAR;
            PG8_LDB(B0, 1, 0); PG8_SCHED; PG8_LDA(At, 1, 0); PG8_STAGE(PG8_SA(0, 1), a2 + hstep, voffA);
            PG8_WAIT_L(8); PG8_BAR; PG8_WAIT_L(0); PG8_MMA(0, 0, At, B0); PG8_BAR; PG8_SCHED;
            PG8_LDB(B1, 1, 1); PG8_STAGE(PG8_SB(1, 0), b3, voffB);
            PG8_BAR; PG8_WAIT_L(0); PG8_MMA(0, 1, At, B1); PG8_BAR;
            PG8_LDA(At, 1, 1); PG8_STAGE(PG8_SA(1, 0), a3, voffA);
            PG8_BAR; PG8_WAIT_L(0); PG8_MMA(1, 0, At, B0); PG8_BAR; PG8_SCHED;
            PG8_STAGE(PG8_SB(1, 1), b3 + hstep, voffB);
            PG8_WAIT_V(6); PG8_BAR; PG8_MMA(1, 1, At, B1); PG8_BAR;
            }
        }
        if constexpr (ALIGN_EPI) { if (wr == 0) PG8_BAR; }
        if constexpr (!Epi::AFTER_DRAIN) { E(acc, cur, wr, wc, fr, fq); S.done(cur); }
        if (!has_next) break;
#pragma unroll
        for (int a = 0; a < 2; ++a)
#pragma unroll
            for (int b = 0; b < 2; ++b)
#pragma unroll
                for (int m = 0; m < 4; ++m)
#pragma unroll
                    for (int n = 0; n < 2; ++n) acc[a][b][m][n] = (f32x4){0.f, 0.f, 0.f, 0.f};
        cur = nxt; cA = nA; cB = nB; ++ui;
        if constexpr (ALIGN_EPI) { if (wr == 1) PG8_BAR; }
    }
    PG8_WAIT_V(0);
    if constexpr (!ALIGN_EPI) { if (wr == 0) PG8_BAR; }
    PG8_BAR;
    if constexpr (Epi::AFTER_DRAIN) { E.fused(acc, cur, wr, wc, fr, fq, lds, wid, lane); S.done(cur); }
#undef PG8_SA
#undef PG8_SB
#undef PG8_STAGE
#undef PG8_LDA
#undef PG8_LDB
#undef PG8_MMA
#undef PG8_WAIT_V
#undef PG8_WAIT_L
#undef PG8_BAR
#undef PG8_SCHED
}
}

constexpr int NWAVES = 8;
constexpr int D = 1024, DFF = 2816, NQKV = 1536;
constexpr int ROWS_P = 16 * 2048, ROWS_S = 8 * 8192, M = ROWS_P + ROWS_S;
constexpr float EPS = 1e-6f, LOG2E = 1.44269504089f;
#ifndef MK_SINGLE
#define MK_SINGLE 1
#endif
constexpr int NPHASES = 18;
constexpr int STAGGER_RESID = 0, STAGGER_BF16 = 0;
#ifndef PROBE_MSPLIT
#define PROBE_MSPLIT 0
#endif
#ifndef PROBE_NOBAR
#define PROBE_NOBAR 0
#endif
#ifndef PROBE_NOSTORE
#define PROBE_NOSTORE 0
#endif
#ifndef PROBE_SYNCS
#define PROBE_SYNCS 0
#endif
#ifndef PROBE_DIAG
#define PROBE_DIAG 0
#endif
#ifndef REPEAT_N
#define REPEAT_N 4
#endif
#ifndef REPEAT_MASK
#define REPEAT_MASK 0
#endif

constexpr size_t MiB = 1u << 20;
constexpr size_t WS_CTL = 0, CTL_ZERO_BYTES = 16384;
constexpr size_t WS_WQKVA = 2 * MiB;
constexpr size_t WS_WOA   = 5 * MiB;
constexpr size_t WS_WQKVB = 7 * MiB;
constexpr size_t WS_WOB   = 16 * MiB;
constexpr size_t WS_WGU   = 18 * MiB;
constexpr size_t WS_WDN   = 40 * MiB;
constexpr size_t WS_H     = 64 * MiB;
constexpr size_t WS_QKV   = 256 * MiB;
constexpr size_t WS_O0    = 544 * MiB;
constexpr size_t WS_O1    = 736 * MiB;
constexpr size_t WS_LSE   = 928 * MiB;
constexpr size_t WS_ACT   = 256 * MiB;
constexpr size_t WS_RSS   = 944 * MiB;
constexpr size_t WS_END   = 964 * MiB;
static_assert(WS_ACT + (size_t)M * DFF * 2 <= WS_LSE && WS_LSE + (size_t)2 * M * 16 * 4 <= WS_RSS && WS_RSS + (size_t)3 * M * 64 <= WS_END && WS_END <= 1024 * MiB, "ws map");

constexpr int LDS_BYTES = 147456;

#define LAS __attribute__((address_space(3)))
typedef unsigned short bf16;
typedef float f32x4 __attribute__((ext_vector_type(4)));
typedef float f32x16 __attribute__((ext_vector_type(16)));
typedef short bf16x8 __attribute__((ext_vector_type(8)));
typedef short s16x4 __attribute__((ext_vector_type(4)));
typedef unsigned u32x4 __attribute__((ext_vector_type(4)));
typedef unsigned u32x2 __attribute__((ext_vector_type(2)));
typedef float f32x2p __attribute__((ext_vector_type(2)));
using pg8::cvt_pk_bf16;
__device__ __forceinline__ float bf2f(short s) { return __builtin_bit_cast(float, (unsigned)(unsigned short)s << 16); }
__device__ __forceinline__ float wave_sum(float v) {
#pragma unroll
    for (int o = 1; o < 64; o <<= 1) v += __shfl_xor(v, o);
    return v;
}

struct Args { const float* in[16]; float* out; unsigned char* ws; int ph_lo, ph_hi; };

__device__ __forceinline__ int colperm_row(int n0) { const int cl = n0 & 255, b = cl >> 5; return (n0 - cl) + 128 * (b & 1) + 32 * (b >> 1); }
__device__ __forceinline__ void transpose_item(const float* W, int K, int N, bf16* WT, int k0, int n0, int drow0, LAS float* scr, int lane, const float* gfold = nullptr) {
    f32x4 wv[8];
#pragma unroll
    for (int i = 0; i < 8; ++i) wv[i] = *(const f32x4*)(W + (size_t)(k0 + 8 * i + (lane >> 3)) * N + n0 + 4 * (lane & 7));
#pragma unroll
    for (int i = 0; i < 8; ++i) { const int kk = 8 * i + (lane >> 3); const float gf = gfold ? gfold[k0 + kk] : 1.0f; LAS float* d = scr + kk * 33 + 4 * (lane & 7);
        d[0] = wv[i].x * gf; d[1] = wv[i].y * gf; d[2] = wv[i].z * gf; d[3] = wv[i].w * gf; }
    asm volatile("s_waitcnt lgkmcnt(0)" ::: "memory");
    const int c = lane & 7;
#pragma unroll
    for (int j = 0; j < 4; ++j) { const int n = (lane >> 3) + 8 * j; const LAS float* s = scr + (8 * c) * 33 + n;
        u32x4 o; o.x = cvt_pk_bf16(s[0 * 33], s[1 * 33]); o.y = cvt_pk_bf16(s[2 * 33], s[3 * 33]); o.z = cvt_pk_bf16(s[4 * 33], s[5 * 33]); o.w = cvt_pk_bf16(s[6 * 33], s[7 * 33]);
        *(u32x4*)(WT + (size_t)(drow0 + n) * K + k0 + 8 * c) = o; }
    asm volatile("s_waitcnt lgkmcnt(0)" ::: "memory");
}
__device__ __forceinline__ void prologue_weights(const Args& a, LAS unsigned char* lds, int gw, int NGW, int wave, int lane) {
    LAS float* scr = (LAS float*)(lds + wave * 16384);
    unsigned char* ws = a.ws;
    constexpr int I_QA = 16 * 48, I_O = 16 * 32, I_QB = 16 * 144, I_GU = 16 * 176, I_DN = 44 * 32;
    constexpr int NITEMS = I_QA + I_O + I_QB + I_O + 2 * I_GU + 2 * I_DN;
    for (int it = gw; it < NITEMS; it += NGW) {
        int r = it;
        if (r < I_QA) { transpose_item(a.in[5], D, NQKV, (bf16*)(ws + WS_WQKVA), 64 * (r / 48), 32 * (r % 48), colperm_row(32 * (r % 48)), scr, lane); continue; } r -= I_QA;
        if (r < I_O)  { transpose_item(a.in[9], D, D, (bf16*)(ws + WS_WOA), 64 * (r / 32), 32 * (r % 32), colperm_row(32 * (r % 32)), scr, lane); continue; } r -= I_O;
        if (r < I_QB) { transpose_item(a.in[10], D, 3 * NQKV, (bf16*)(ws + WS_WQKVB), 64 * (r / 144), 32 * (r % 144), colperm_row(32 * (r % 144)), scr, lane, a.in[3] + D); continue; } r -= I_QB;
        if (r < I_O)  { transpose_item(a.in[13], D, D, (bf16*)(ws + WS_WOB), 64 * (r / 32), 32 * (r % 32), colperm_row(32 * (r % 32)), scr, lane); continue; } r -= I_O;
        if (r < 2 * I_GU) { const int l = r / I_GU; r -= l * I_GU; const int n0 = 32 * (r % 176); const int f = n0 < DFF ? n0 : n0 - DFF;
            const int drow = 256 * (f / 128) + (n0 < DFF ? 0 : 128) + (f % 128);
            transpose_item(a.in[14] + (size_t)l * D * 2 * DFF, D, 2 * DFF, (bf16*)(ws + WS_WGU) + (size_t)l * 2 * DFF * D, 64 * (r / 176), n0, drow, scr, lane, a.in[4] + l * D); continue; } r -= 2 * I_GU;
        { const int l = r / I_DN; r -= l * I_DN;
            transpose_item(a.in[15] + (size_t)l * DFF * D, DFF, D, (bf16*)(ws + WS_WDN) + (size_t)l * D * DFF, 64 * (r / 32), 32 * (r % 32), colperm_row(32 * (r % 32)), scr, lane); }
    }
}
__device__ __forceinline__ void norm_phase(const float* x0, const float* x1, const float* g, bf16* H, int gw, int NGW, int lane) {
    f32x4 gv[4];
#pragma unroll
    for (int j = 0; j < 4; ++j) gv[j] = *(const f32x4*)(g + 4 * lane + 256 * j);
    for (int m0 = gw; m0 < M; m0 += 2 * NGW) {
        const int m1 = m0 + NGW; const bool has1 = m1 < M; const int m1c = has1 ? m1 : m0;
        const float* xr0 = (m0 < ROWS_P) ? x0 + (size_t)m0 * D : x1 + (size_t)(m0 - ROWS_P) * D;
        const float* xr1 = (m1c < ROWS_P) ? x0 + (size_t)m1c * D : x1 + (size_t)(m1c - ROWS_P) * D;
        f32x4 v[4], w[4]; float s = 0.f, t = 0.f;
#pragma unroll
        for (int j = 0; j < 4; ++j) { v[j] = *(const f32x4*)(xr0 + 4 * lane + 256 * j); w[j] = *(const f32x4*)(xr1 + 4 * lane + 256 * j); }
#pragma unroll
        for (int j = 0; j < 4; ++j) { s += (v[j].x * v[j].x + v[j].y * v[j].y) + (v[j].z * v[j].z + v[j].w * v[j].w); t += (w[j].x * w[j].x + w[j].y * w[j].y) + (w[j].z * w[j].z + w[j].w * w[j].w); }
        const float rstd0 = __builtin_amdgcn_rsqf(wave_sum(s) * (1.0f / D) + EPS), rstd1 = __builtin_amdgcn_rsqf(wave_sum(t) * (1.0f / D) + EPS);
        bf16* orow0 = H + (size_t)m0 * D + 4 * lane; bf16* orow1 = H + (size_t)m1c * D + 4 * lane;
#pragma unroll
        for (int j = 0; j < 4; ++j) { const f32x4 a_ = v[j] * rstd0 * gv[j]; u32x2 o; o.x = cvt_pk_bf16(a_.x, a_.y); o.y = cvt_pk_bf16(a_.z, a_.w); *(u32x2*)(orow0 + 256 * j) = o; }
        if (has1) {
#pragma unroll
            for (int j = 0; j < 4; ++j) { const f32x4 a_ = w[j] * rstd1 * gv[j]; u32x2 o; o.x = cvt_pk_bf16(a_.x, a_.y); o.y = cvt_pk_bf16(a_.z, a_.w); *(u32x2*)(orow1 + 256 * j) = o; } }
    }
}

__device__ __forceinline__ float xhalf_max(float m) { auto rr = __builtin_amdgcn_permlane32_swap(__builtin_bit_cast(unsigned, m), __builtin_bit_cast(unsigned, m), false, false); return fmaxf(__builtin_bit_cast(float, rr[0]), __builtin_bit_cast(float, rr[1])); }
__device__ __forceinline__ float xhalf_sum(float m) { auto rr = __builtin_amdgcn_permlane32_swap(__builtin_bit_cast(unsigned, m), __builtin_bit_cast(unsigned, m), false, false); return __builtin_bit_cast(float, rr[0]) + __builtin_bit_cast(float, rr[1]); }
struct AttU { int kvh, rowp, rown, Ls, t0; };
__device__ __forceinline__ AttU att_decode(int kvh, int tile, int dsh) {
    AttU a; a.kvh = kvh; int seq_row0, lsh, tin;
    if (tile < 512) { seq_row0 = (tile >> 5) * 2048; lsh = 11; tin = tile & 31; }
    else { const int t2 = tile - 512; seq_row0 = ROWS_P + (t2 >> 7) * 8192; lsh = 13; tin = t2 & 127; }
    const int tsh = lsh - dsh - 6, r = tin >> tsh; a.Ls = 1 << (lsh - dsh); a.rown = seq_row0 + r; a.rowp = seq_row0 + r * a.Ls; a.t0 = (tin & ((1 << tsh) - 1)) * 64; return a;
}
__device__ __forceinline__ bool att_unit(int i, int G, int bid, int& kvh, int& tile) {
    constexpr int NT = 16 * 32 + 8 * 128;
    if (G == 256) { const int xcd = bid & 7; kvh = xcd & 3; tile = (2 * i + (xcd >> 2)) * 32 + (bid >> 3); return tile < NT; }
    const int u = bid + i * G; kvh = u & 3; tile = u >> 2; return tile < NT;
}
template <int HW, int MODE, int DIAG = 0>
__device__ __forceinline__ void attn_phase(LAS unsigned char* lds, const bf16* __restrict__ QKV, bf16* O, const bf16* P1, float* LSEw, const float* LSE0, const float* LSE1,
                                           int dsh, const float* gq, const float* gk, const float* sink, const float* rel_table, int G, int bid, const int tid) {
    constexpr int NK = 64 + 2 * HW, KST = 144, VST = NK * 2 + 8, TBN = 2 * HW + 64 + 16, NPASS = NK / 64;
    constexpr int NVIT = NK * 2, NVI = (NVIT + 511) / 512;
    constexpr int KS_OFF = 0, VT_OFF = NK * KST, TB_OFF = VT_OFF + 64 * VST, GQ_OFF = TB_OFF + 16 * TBN * 4;
    constexpr bool LTR = true;
    constexpr int OST_OFF = GQ_OFF + 512, OST_W = 32 * 144;
    static_assert(OST_OFF + 8 * OST_W <= LDS_BYTES - 64, "attention LDS (the grid barrier's two words sit in the last 64 bytes)");
    const int lane = tid & 63, w = __builtin_amdgcn_readfirstlane(tid >> 6), hh = w >> 1, half = w & 1;
    const int ql = lane & 31, g2 = lane >> 5;
    const int skk = tid >> 3, sdc = tid & 7;
    float gkr[8];
#pragma unroll
    for (int i = 0; i < 8; ++i) gkr[i] = gk[sdc * 8 + i];
    LAS float* Tb = (LAS float*)(lds + TB_OFF);
    LAS float* Gq = (LAS float*)(lds + GQ_OFF);
    LAS float* Sh = (LAS float*)(lds + GQ_OFF + 256);
    if (tid < 64) Gq[tid] = gq[tid] * (0.125f * LOG2E);
    int tb_kvh = -1;
    bf16x8 kraw[NPASS], vraw[NVI][4], qr[4];
    u32x4 pra[4], prb[4]; float pl0 = 0.f, pl1 = 0.f;
#define ATT_LOADS(au) do { \
        const bf16* base_ = QKV + (size_t)(au).rowp * NQKV; \
          \
        _Pragma("unroll") for (int p = 0; p < NPASS; ++p) { int t = (au).t0 - HW + p * 64 + skk; t = t < 0 ? 0 : (t >= (au).Ls ? (au).Ls - 1 : t); \
            kraw[p] = *(const bf16x8*)(base_ + (size_t)t * NQKV + D + (au).kvh * 64 + sdc * 8); } \
        _Pragma("unroll") for (int iv = 0; iv < NVI; ++iv) { const int it = tid + 512 * iv, kg = (it < NVIT ? it : tid) >> 3; \
            _Pragma("unroll") for (int jj = 0; jj < 4; ++jj) { int t = (au).t0 - HW + 4 * kg + jj; t = t < 0 ? 0 : (t >= (au).Ls ? (au).Ls - 1 : t); \
                vraw[iv][jj] = *(const bf16x8*)(base_ + (size_t)t * NQKV + D + 256 + (au).kvh * 64 + sdc * 8); } } \
        { const bf16* qp_ = base_ + (size_t)((au).t0 + 32 * half + ql) * NQKV + ((au).kvh * 4 + hh) * 64 + 8 * g2; \
            _Pragma("unroll") for (int ks = 0; ks < 4; ++ks) qr[ks] = *(const bf16x8*)(qp_ + 16 * ks); } \
        if (MODE == 2) { const size_t rq_ = (size_t)((au).rown + (((au).t0 + 32 * half + ql) << dsh)); const int h_ = (au).kvh * 4 + hh; \
            const size_t ro_ = ((size_t)((au).rown + (((au).t0 + 32 * half + (lane >> 3)) << dsh)) * D + h_ * 64 + 8 * (lane & 7)); \
            _Pragma("unroll") for (int it = 0; it < 4; ++it) { pra[it] = *(const u32x4*)(O + ro_ + ((size_t)(8 * it) << dsh) * D); prb[it] = *(const u32x4*)(P1 + ro_ + ((size_t)(8 * it) << dsh) * D); } \
            pl0 = LSE0[rq_ * 16 + h_]; pl1 = LSE1[rq_ * 16 + h_]; } \
    } while (0)
    constexpr bool DEFER = (MODE == 1);
    float lse_st = 0.f; float* lp_st = nullptr; bool have_st = false; int rb_st = 0, h_st = 0;
    LAS unsigned char* ostw = lds + OST_OFF + w * OST_W;
#define ATT_ROWS_OUT(rb, hd) do { if (DIAG == 0) { _Pragma("unroll") for (int it = 0; it < 4; ++it) { const int r_ = 8 * it + (lane >> 3), ch_ = lane & 7; \
        const u32x4 d_ = *(const LAS u32x4*)(ostw + r_ * 144 + ch_ * 16); *(u32x4*)(O + (size_t)((rb) + (r_ << dsh)) * D + (hd) * 64 + ch_ * 8) = d_; } } } while (0)
#define ATT_FLUSH() do { if (have_st) { ATT_ROWS_OUT(rb_st, h_st); if (DIAG == 0 && MODE == 1 && g2 == 0) *lp_st = lse_st; } } while (0)
    int ui = 0, ukvh, utile;
    bool have = att_unit(0, G, bid, ukvh, utile);
    AttU cu = att_decode(have ? ukvh : 0, have ? utile : 0, dsh);
    ATT_LOADS(cu);
    for (; have; ++ui) {
        const int kvh = cu.kvh, t0 = cu.t0, Ls = cu.Ls;
        const int h = kvh * 4 + hh;
        const int cu_rown = cu.rown;
        const int rowq = cu.rown + ((t0 + 32 * half + ql) << dsh);
        if (kvh != tb_kvh) {
            float gqm = 0.f, gkm = 0.f;
            for (int i = 0; i < 64; ++i) { gqm = fmaxf(gqm, fabsf(gq[i])); gkm = fmaxf(gkm, fabsf(gk[i])); }
            float sh[4];
#pragma unroll
            for (int hq = 0; hq < 4; ++hq) { float bm = -1e30f; for (int b = 0; b < 32; ++b) bm = fmaxf(bm, rel_table[b * 16 + kvh * 4 + hq]); sh[hq] = (8.0f * gqm * gkm + bm) * LOG2E; }
            if (tid < 4) Sh[tid] = tid == 0 ? sh[0] : tid == 1 ? sh[1] : tid == 2 ? sh[2] : sh[3];
            for (int e = tid; e < 16 * TBN; e += NWAVES * 64) {
                const int hq = e / (4 * TBN), b4 = (e / TBN) & 3, j = e % TBN, idx = j + 3 - b4, rel = idx - 31 - HW; float v = -1e30f;
                if (rel >= -HW && rel <= HW) { const int off = rel * (1 << dsh), n = off < 0 ? -off : off;
                    int b = n < 8 ? n : (n < 15 ? 8 : n < 27 ? 9 : n < 50 ? 10 : n < 91 ? 11 : n < 166 ? 12 : n < 305 ? 13 : n < 559 ? 14 : 15);
                    b += off > 0 ? 16 : 0; v = rel_table[b * 16 + kvh * 4 + hq] * LOG2E - (hq == 0 ? sh[0] : hq == 1 ? sh[1] : hq == 2 ? sh[2] : sh[3]); }
                Tb[e] = v; }
            tb_kvh = kvh;
        }
        if (DIAG == 3) { _Pragma("unroll") for (int p = 0; p < NPASS; ++p) asm volatile("" :: "v"(kraw[p])); _Pragma("unroll") for (int iv = 0; iv < NVI; ++iv) _Pragma("unroll") for (int jj = 0; jj < 4; ++jj) asm volatile("" :: "v"(vraw[iv][jj])); }
        if (DIAG != 3)
#pragma unroll
        for (int p = 0; p < NPASS; ++p) {
            const int kk = p * 64 + skk; float f[8]; float ss = 0.f;
#pragma unroll
            for (int j = 0; j < 8; ++j) { f[j] = bf2f(kraw[p][j]); ss += f[j] * f[j]; }
            ss += __shfl_xor(ss, 1); ss += __shfl_xor(ss, 2); ss += __shfl_xor(ss, 4);
            const float rs = __builtin_amdgcn_rsqf(ss * (1.0f / 64.0f) + EPS);
            u32x4 pk; pk.x = cvt_pk_bf16(f[0] * rs * gkr[0], f[1] * rs * gkr[1]); pk.y = cvt_pk_bf16(f[2] * rs * gkr[2], f[3] * rs * gkr[3]);
            pk.z = cvt_pk_bf16(f[4] * rs * gkr[4], f[5] * rs * gkr[5]); pk.w = cvt_pk_bf16(f[6] * rs * gkr[6], f[7] * rs * gkr[7]);
            *(LAS u32x4*)(lds + KS_OFF + kk * KST + sdc * 16) = pk;
        }
        if (DIAG != 3)
#pragma unroll
        for (int iv = 0; iv < NVI; ++iv) { const int it = tid + 512 * iv, kg = it >> 3;
            if (it < NVIT) {
#pragma unroll
                for (int j = 0; j < 8; ++j) { const s16x4 t4 = {vraw[iv][0][j], vraw[iv][1][j], vraw[iv][2][j], vraw[iv][3][j]};
                    *(LAS s16x4*)(lds + VT_OFF + (sdc * 8 + j) * VST + kg * 8) = t4; } } }
        __syncthreads();
        bf16x8 qf[4];
        {
            float ss = 0.f;
#pragma unroll
            for (int ks = 0; ks < 4; ++ks)
#pragma unroll
                for (int j = 0; j < 8; ++j) { const float f = bf2f(qr[ks][j]); ss += f * f; }
            ss += __shfl_xor(ss, 32);
            const float rs = __builtin_amdgcn_rsqf(ss * (1.0f / 64.0f) + EPS);
#pragma unroll
            for (int ks = 0; ks < 4; ++ks) { const f32x4 ga = *(const LAS f32x4*)(Gq + 16 * ks + 8 * g2), gb = *(const LAS f32x4*)(Gq + 16 * ks + 8 * g2 + 4); u32x4 pk;
                pk.x = cvt_pk_bf16(bf2f(qr[ks][0]) * rs * ga[0], bf2f(qr[ks][1]) * rs * ga[1]); pk.y = cvt_pk_bf16(bf2f(qr[ks][2]) * rs * ga[2], bf2f(qr[ks][3]) * rs * ga[3]);
                pk.z = cvt_pk_bf16(bf2f(qr[ks][4]) * rs * gb[0], bf2f(qr[ks][5]) * rs * gb[1]); pk.w = cvt_pk_bf16(bf2f(qr[ks][6]) * rs * gb[2], bf2f(qr[ks][7]) * rs * gb[3]);
                qf[ks] = __builtin_bit_cast(bf16x8, pk); }
        }
        f32x16 o0, o1; float lsum = 0.f;
        if (MODE == 2) { const float w0 = __builtin_amdgcn_exp2f(pl0 - Sh[hh]), w1 = __builtin_amdgcn_exp2f(pl1 - Sh[hh]);
#pragma unroll
            for (int it = 0; it < 4; ++it) *(LAS u32x4*)(ostw + (8 * it + (lane >> 3)) * 144 + 16 * (lane & 7)) = pra[it];
            asm volatile("" ::: "memory");
#pragma unroll
            for (int q4 = 0; q4 < 4; ++q4) { const s16x4 a0 = *(const LAS s16x4*)(ostw + ql * 144 + (8 * q4 + 4 * g2) * 2), a1 = *(const LAS s16x4*)(ostw + ql * 144 + (32 + 8 * q4 + 4 * g2) * 2);
#pragma unroll
                for (int j = 0; j < 4; ++j) { o0[4 * q4 + j] = w0 * bf2f(a0[j]); o1[4 * q4 + j] = w0 * bf2f(a1[j]); } }
            asm volatile("" ::: "memory");
#pragma unroll
            for (int it = 0; it < 4; ++it) *(LAS u32x4*)(ostw + (8 * it + (lane >> 3)) * 144 + 16 * (lane & 7)) = prb[it];
            asm volatile("" ::: "memory");
#pragma unroll
            for (int q4 = 0; q4 < 4; ++q4) { const s16x4 b0 = *(const LAS s16x4*)(ostw + ql * 144 + (8 * q4 + 4 * g2) * 2), b1 = *(const LAS s16x4*)(ostw + ql * 144 + (32 + 8 * q4 + 4 * g2) * 2);
#pragma unroll
                for (int j = 0; j < 4; ++j) { o0[4 * q4 + j] += w1 * bf2f(b0[j]); o1[4 * q4 + j] += w1 * bf2f(b1[j]); } }
            asm volatile("" ::: "memory");
            lsum = g2 == 0 ? w0 + w1 : 0.f; }
        else {
#pragma unroll
            for (int i = 0; i < 16; ++i) { o0[i] = 0.f; o1[i] = 0.f; } }
        if (DEFER) ATT_FLUSH();
        { int nk, nt; have = att_unit(ui + 1, G, bid, nk, nt); if (have) cu = att_decode(nk, nt, dsh); ATT_LOADS(cu); }
        const float mrun = Sh[hh];
        int c_lo = half, c_hi = half + HW / 16;
        { const int lo2 = (HW - t0 + 31) >> 5, hi2 = ((Ls + HW - t0) >> 5) - 1; c_lo = lo2 > c_lo ? lo2 : c_lo; c_hi = hi2 < c_hi ? hi2 : c_hi; }
        if (DIAG == 2 || DIAG == 3) c_hi = c_lo - 1;
        const LAS unsigned char* kbase = lds + KS_OFF + ql * KST + 16 * g2;
        const LAS float* tbase = Tb + (hh * 4 + (ql & 3)) * TBN + 28 - (ql & ~3) + 4 * g2 - 32 * half;
        const LAS unsigned char* vbase = lds + VT_OFF + ql * VST + 8 * g2;
        f32x16 sc;
        {
            bf16x8 ka[4]; f32x4 bz[4];
#pragma unroll
            for (int ks = 0; ks < 4; ++ks) ka[ks] = *(const LAS bf16x8*)(kbase + c_lo * 32 * KST + 32 * ks);
#pragma unroll
            for (int q4 = 0; q4 < 4; ++q4) bz[q4] = *(const LAS f32x4*)(tbase + 32 * c_lo + 8 * q4);
#pragma unroll
            for (int i = 0; i < 16; ++i) sc[i] = bz[i >> 2][i & 3];
#pragma unroll
            for (int ks = 0; ks < 4; ++ks) sc = __builtin_amdgcn_mfma_f32_32x32x16_bf16(ka[ks], qf[ks], sc, 0, 0, 0);
        }
        f32x2p ls2 = {0.f, 0.f};
        for (int c = c_lo; c <= c_hi; ++c) {
            const int cn = c < c_hi ? c + 1 : c;
            bf16x8 kn[4]; f32x4 bn[4]; s16x4 vf[2][4];
#pragma unroll
            for (int ks = 0; ks < 4; ++ks) kn[ks] = *(const LAS bf16x8*)(kbase + cn * 32 * KST + 32 * ks);
#pragma unroll
            for (int q4 = 0; q4 < 4; ++q4) bn[q4] = *(const LAS f32x4*)(tbase + 32 * cn + 8 * q4);
#pragma unroll
            for (int mt = 0; mt < 2; ++mt)
#pragma unroll
                for (int j = 0; j < 4; ++j) vf[mt][j] = *(const LAS s16x4*)(vbase + mt * 32 * VST + c * 64 + 16 * j);
            f32x16 sn;
#pragma unroll
            for (int i = 0; i < 16; ++i) sn[i] = bn[i >> 2][i & 3];
#pragma unroll
            for (int ks = 0; ks < 4; ++ks) { if (DIAG == 5) { sn[ks] += bf2f(kn[ks][0]) * bf2f(qf[ks][0]); } else sn = __builtin_amdgcn_mfma_f32_32x32x16_bf16(kn[ks], qf[ks], sn, 0, 0, 0); }
            float pr[16];
#pragma unroll
            for (int i = 0; i < 16; ++i) pr[i] = DIAG == 4 ? sc[i] * 1.0001f : __builtin_amdgcn_exp2f(sc[i]);
#pragma unroll
            for (int i = 0; i < 8; ++i) ls2 += (f32x2p){pr[2 * i], pr[2 * i + 1]};
            u32x4 pa, pb;
            pa.x = cvt_pk_bf16(pr[0], pr[1]); pa.y = cvt_pk_bf16(pr[2], pr[3]); pa.z = cvt_pk_bf16(pr[4], pr[5]); pa.w = cvt_pk_bf16(pr[6], pr[7]);
            pb.x = cvt_pk_bf16(pr[8], pr[9]); pb.y = cvt_pk_bf16(pr[10], pr[11]); pb.z = cvt_pk_bf16(pr[12], pr[13]); pb.w = cvt_pk_bf16(pr[14], pr[15]);
            const bf16x8 p0 = __builtin_bit_cast(bf16x8, pa), p1 = __builtin_bit_cast(bf16x8, pb);
            if (DIAG == 5) { o0[0] += bf2f(vf[0][0][0]) * bf2f(p0[0]); o1[0] += bf2f(vf[1][0][0]) * bf2f(p0[1]); o0[1] += bf2f(vf[0][2][0]) * bf2f(p1[0]); o1[1] += bf2f(vf[1][2][0]) * bf2f(p1[1]); o0[2] += bf2f(vf[0][1][0]) + bf2f(vf[0][3][0]) + bf2f(vf[1][1][0]) + bf2f(vf[1][3][0]); } else {
            o0 = __builtin_amdgcn_mfma_f32_32x32x16_bf16(__builtin_shufflevector(vf[0][0], vf[0][1], 0, 1, 2, 3, 4, 5, 6, 7), p0, o0, 0, 0, 0);
            o1 = __builtin_amdgcn_mfma_f32_32x32x16_bf16(__builtin_shufflevector(vf[1][0], vf[1][1], 0, 1, 2, 3, 4, 5, 6, 7), p0, o1, 0, 0, 0);
            o0 = __builtin_amdgcn_mfma_f32_32x32x16_bf16(__builtin_shufflevector(vf[0][2], vf[0][3], 0, 1, 2, 3, 4, 5, 6, 7), p1, o0, 0, 0, 0);
            o1 = __builtin_amdgcn_mfma_f32_32x32x16_bf16(__builtin_shufflevector(vf[1][2], vf[1][3], 0, 1, 2, 3, 4, 5, 6, 7), p1, o1, 0, 0, 0); }
            sc = sn;
        }
        lsum += ls2.x + ls2.y;
        lsum += __shfl_xor(lsum, 32);
        if (MODE == 0) lsum += __builtin_amdgcn_exp2f(sink[h] * LOG2E - mrun);
        const float f2 = __builtin_amdgcn_rcpf(lsum);
        if (MODE == 1) { lse_st = mrun + __builtin_amdgcn_logf(lsum); lp_st = LSEw + (size_t)rowq * 16 + h; if (!DEFER && DIAG == 0 && g2 == 0) *lp_st = lse_st; }
        bf16* op = O + (size_t)rowq * D + h * 64 + 4 * g2;
#pragma unroll
        for (int mt = 0; mt < 2; ++mt)
#pragma unroll
            for (int q4 = 0; q4 < 4; ++q4) {
                float v[4];
#pragma unroll
                for (int j = 0; j < 4; ++j) v[j] = (mt == 0 ? o0[4 * q4 + j] : o1[4 * q4 + j]) * f2;
                u32x2 o; o.x = cvt_pk_bf16(v[0], v[1]); o.y = cvt_pk_bf16(v[2], v[3]);
                if (LTR) *(LAS u32x2*)(ostw + ql * 144 + (mt * 32 + 8 * q4 + 4 * g2) * 2) = o;
                else { if (DIAG == 0) *(u32x2*)(op + mt * 32 + 8 * q4) = o; else asm volatile("" :: "v"(o)); }
            }
        if (LTR) { const int rb = cu_rown + ((t0 + 32 * half) << dsh);
            if (DEFER) { rb_st = rb; h_st = h; have_st = true; } else ATT_ROWS_OUT(rb, h); }
        __syncthreads();
    }
    if (DEFER) ATT_FLUSH();
#undef ATT_FLUSH
#undef ATT_ROWS_OUT
#undef ATT_LOADS
}


#define XB_TMO      128
#define XB_XCNT(j)  (256  + 64 * (j))
#define XB_XSUB(j)  (1280 + 64 * (j))
#define XB_XGEN(j)  (2304 + 64 * (j))
#define XB_TOP      3328
#define XB_TOPGEN   3392
#define XCD_BAR_WORDS 3456
#define XB_SPIN_CAP (1u << 18)

__device__ __forceinline__ unsigned xb_ld(unsigned* p)              { return __hip_atomic_load(p, __ATOMIC_RELAXED, __HIP_MEMORY_SCOPE_AGENT); }
__device__ __forceinline__ unsigned xb_add(unsigned* p, unsigned v) { return __hip_atomic_fetch_add(p, v, __ATOMIC_RELAXED, __HIP_MEMORY_SCOPE_AGENT); }
__device__ __forceinline__ unsigned xb_xcc_id() { return (unsigned)__builtin_amdgcn_s_getreg((3 << 11) | 20) & 0xFu; }
#define XB_SPIN(cond, bar) do { unsigned _sp = 0; while (cond) { __builtin_amdgcn_s_sleep(1); \
    if ((++_sp & 255u) == 0u) { if (xb_ld(&(bar)[XB_TMO])) break; if (_sp > XB_SPIN_CAP) { atomicAdd(&(bar)[XB_TMO], 1u); break; } } } } while (0)

struct XcdBarrier {
    unsigned* bar; unsigned x;
    volatile LAS unsigned* st;
};

__device__ __forceinline__ XcdBarrier xcd_barrier_post(unsigned* bar, volatile LAS unsigned* st) {
    XcdBarrier b; b.bar = bar; b.x = xb_xcc_id(); b.st = st;
    if (threadIdx.x == 0) (void)xb_add(&bar[XB_XCNT(b.x)], 1u);
    return b;
}
__device__ __forceinline__ void xcd_barrier_complete(unsigned* bar, unsigned x, unsigned& nloc, unsigned& nx) {
    const unsigned G = gridDim.x * gridDim.y * gridDim.z;
    unsigned sum, cnt, mine, sp = 0u;
    for (;;) {
        sum = 0u; cnt = 0u; mine = 0u;
#pragma unroll
        for (unsigned j = 0; j < 16; ++j) { const unsigned c = xb_ld(&bar[XB_XCNT(j)]); sum += c; cnt += (c > 0u) ? 1u : 0u; mine = (j == x) ? c : mine; }
        if (sum == G) break;
        __builtin_amdgcn_s_sleep(1);
        if ((++sp & 255u) == 0u) { if (xb_ld(&bar[XB_TMO])) break; if (sp > XB_SPIN_CAP) { atomicAdd(&bar[XB_TMO], 1u); break; } }
    }
    nloc = mine > 0u ? mine : 1u; nx = cnt > 0u ? cnt : 1u;
}

__device__ __forceinline__ void xcd_barrier(const XcdBarrier& b) {
    asm volatile("s_waitcnt vmcnt(0)" ::: "memory");
    __syncthreads();
    if (threadIdx.x == 0) {
        unsigned* bar = b.bar;
        __builtin_amdgcn_s_waitcnt(0);
        unsigned nloc = b.st[0], nx = b.st[1];
        if (nloc == 0u) { xcd_barrier_complete(bar, b.x, nloc, nx); b.st[0] = nloc; b.st[1] = nx; }
        const unsigned old = xb_add(&bar[XB_XSUB(b.x)], 1u);
        const unsigned gen = old / nloc;
        if (old + 1u == (gen + 1u) * nloc) {
            __builtin_amdgcn_fence(__ATOMIC_RELEASE, "agent");
            asm volatile("s_waitcnt vmcnt(0)" ::: "memory");
            const unsigned og = xb_add(&bar[XB_TOP], 1u);
            const unsigned tg = og / nx;
            if (og + 1u == (tg + 1u) * nx) xb_add(&bar[XB_TOPGEN], 1u);
            else XB_SPIN(xb_ld(&bar[XB_TOPGEN]) == tg, bar);
            __builtin_amdgcn_fence(__ATOMIC_ACQUIRE, "agent");
            xb_add(&bar[XB_XGEN(b.x)], 1u);
            asm volatile("s_waitcnt vmcnt(0)" ::: "memory");
        } else {
            XB_SPIN(xb_ld(&bar[XB_XGEN(b.x)]) == gen, bar);
            __builtin_amdgcn_fence(__ATOMIC_ACQUIRE, "agent");
            asm volatile("s_waitcnt vmcnt(0)" ::: "memory");
        }
    }
    __syncthreads();
}


__global__ void __launch_bounds__(NWAVES * 64, 2) fwd_megakernel(Args a) {
    extern __shared__ __attribute__((aligned(16))) unsigned char lds_raw[];
    LAS unsigned char* lds = (LAS unsigned char*)lds_raw;
    cg::grid_group grid = cg::this_grid();
    const int G = gridDim.x, bid = blockIdx.x;
    unsigned char* ws = a.ws;
    bf16* H = (bf16*)(ws + WS_H); bf16* QKV = (bf16*)(ws + WS_QKV); bf16* O0 = (bf16*)(ws + WS_O0); bf16* O1 = (bf16*)(ws + WS_O1); bf16* ACT = (bf16*)(ws + WS_ACT);
    float* LSE0 = (float*)(ws + WS_LSE); float* LSE1 = LSE0 + (size_t)M * 16;
    const float* xin0 = a.in[0]; const float* xin1 = a.in[1]; float* out = a.out;
    float* RSS = (float*)(ws + WS_RSS);

    volatile LAS unsigned* bst = (volatile LAS unsigned*)(lds + LDS_BYTES - 64);
    if (threadIdx.x < 4) bst[threadIdx.x] = 0u;
    __syncthreads();
    const XcdBarrier xbar = xcd_barrier_post((unsigned*)(ws + WS_CTL), bst);
    for (int ph = a.ph_lo, rep = 0; ph < a.ph_hi;) {
        int tid = threadIdx.x; asm volatile("" : "+v"(tid));
        const int lane = tid & 63, wave = __builtin_amdgcn_readfirstlane(tid >> 6), gw = bid * NWAVES + wave, NGW = G * NWAVES;
        if (ph == 0) { prologue_weights(a, lds, gw, NGW, wave, lane); norm_phase(xin0, xin1, a.in[3], H, gw, NGW, lane); }
        else if (ph == 4 || ph == 7 || ph == 15) {
#if PROBE_SYNCS
            if (ph == 4) for (int k = 0; k < PROBE_SYNCS; ++k) grid.sync();
#endif
            ++ph; continue; }
        else if (ph == 1 || ph == 8 || ph == 10 || ph == 12) {
            const bf16* Bt = ph == 1 ? (const bf16*)(ws + WS_WQKVA) : (const bf16*)(ws + WS_WQKVB) + (size_t)((ph - 8) >> 1) * NQKV * D;
            pg8::Gemm g{H, Bt, M, NQKV, D}; pg8::StaticOrder S; S.init(M, NQKV, G, bid);
            pg8::EpiBf16 E{(PROBE_NOSTORE == 2 && rep >= 1) ? ACT + (size_t)M * NQKV : QKV, NQKV, ph == 10 ? 2 : ph == 12 ? 4 : 0, ROWS_P, (PROBE_NOSTORE && rep >= 1) ? PROBE_NOSTORE : 0, ph == 1 ? nullptr : RSS + (size_t)M * 16};
            pg8::gemm_phase<pg8::EpiBf16, pg8::StaticOrder, true, true>(lds, g, S, E, tid, STAGGER_BF16);
        }
        else if (ph == 2) attn_phase<128, 0>(lds, QKV, O0, nullptr, nullptr, nullptr, nullptr, 0, a.in[6], a.in[7], a.in[8], a.in[2], G, bid, tid);
        else if (ph == 9 || ph == 11) {
            const int gi = (ph - 9) >> 1;
#if PROBE_DIAG
            if (rep >= 1) attn_phase<64, 1, PROBE_DIAG>(lds, QKV, gi ? O1 : O0, nullptr, gi ? LSE1 : LSE0, nullptr, nullptr, 2 * gi, a.in[11] + 64 * gi, a.in[12] + 64 * gi, nullptr, a.in[2], G, bid, tid); else
#endif
            attn_phase<64, 1>(lds, QKV, gi ? O1 : O0, nullptr, gi ? LSE1 : LSE0, nullptr, nullptr, 2 * gi, a.in[11] + 64 * gi, a.in[12] + 64 * gi, nullptr, a.in[2], G, bid, tid);
        }
        else if (ph == 13) attn_phase<64, 2>(lds, QKV, O0, O1, nullptr, LSE0, LSE1, 4, a.in[11] + 128, a.in[12] + 128, nullptr, a.in[2], G, bid, tid);
        else if (ph == 3 || ph == 14 || ph == 6 || ph == 17) {
            const bool isdown = (ph == 6 || ph == 17);
            const bf16* A = isdown ? ACT : O0;
            const bf16* Bt = ph == 3 ? (const bf16*)(ws + WS_WOA) : ph == 14 ? (const bf16*)(ws + WS_WOB) : (const bf16*)(ws + WS_WDN) + (size_t)(ph == 17 ? 1 : 0) * D * DFF;
            pg8::Gemm g{A, Bt, M, D, isdown ? DFF : D}; pg8::StaticOrder S; S.init(M, D, G, bid);
            const int rk = ph == 3 ? 0 : ph == 6 ? 1 : 2;
            pg8::EpiResid E{xin0, xin1, ROWS_P, ph == 3 ? 1 : 0, ph == 17 ? 1 : 0, H, out, D, RSS + (size_t)rk * M * 16};
            pg8::gemm_phase<pg8::EpiResid, pg8::StaticOrder, true, true>(lds, g, S, E, tid, STAGGER_RESID);
        }
        else {
            const bf16* Bt = (const bf16*)(ws + WS_WGU) + (size_t)(ph == 16 ? 1 : 0) * 2 * DFF * D;
            const int Mrun = (PROBE_MSPLIT && rep >= 1) ? PROBE_MSPLIT : M;
            pg8::Gemm g{H, Bt, Mrun, 2 * DFF, D}; pg8::StaticOrder S; S.init(Mrun, 2 * DFF, G, bid);
            pg8::EpiSwiglu E{ACT, DFF, RSS + (size_t)(ph == 16 ? 2 : 0) * M * 16};
            pg8::gemm_phase<pg8::EpiSwiglu, pg8::StaticOrder, true, true>(lds, g, S, E, tid, STAGGER_BF16);
        }
        const bool again = ((REPEAT_MASK >> ph) & 1) && rep < REPEAT_N;
        if (PROBE_NOBAR && again) __syncthreads();
        else if (ph + 1 < a.ph_hi || again) { if (a.ph_lo < 0) grid.sync(); else xcd_barrier(xbar); }
        if (again) ++rep; else { rep = 0; ++ph; }
    }
}

extern "C" void kernel_launch(void* const* d_in, const int* in_sizes, int n_in, void* d_out, int out_size, void* d_ws, size_t ws_size, hipStream_t stream) {
    static int grid = 0;
    if (grid == 0) {
        if (n_in != 16 || out_size != M * D || ws_size < WS_END) { fprintf(stderr, "kernel_launch: unexpected shapes (n_in %d out %d ws %zu)\n", n_in, out_size, ws_size); grid = -1; return; }
        int dev = 0, cus = 0, per_cu = 0;
        hipGetDevice(&dev); hipDeviceGetAttribute(&cus, hipDeviceAttributeMultiprocessorCount, dev);
        if (hipFuncSetAttribute((const void*)fwd_megakernel, hipFuncAttributeMaxDynamicSharedMemorySize, LDS_BYTES) != hipSuccess) { fprintf(stderr, "kernel_launch: hipFuncSetAttribute failed\n"); grid = -1; return; }
        hipOccupancyMaxActiveBlocksPerMultiprocessor(&per_cu, (const void*)fwd_megakernel, NWAVES * 64, LDS_BYTES);
        if (per_cu < 1) { fprintf(stderr, "kernel_launch: occupancy query says %d blocks/CU\n", per_cu); per_cu = 1; }
        (void)hipGetLastError();
        grid = cus;
    }
    if (grid < 0) return;
    if (hipMemsetAsync((char*)d_ws + WS_CTL, 0, CTL_ZERO_BYTES, stream) != hipSuccess) { fprintf(stderr, "kernel_launch: hipMemsetAsync failed\n"); return; }
    Args a{};
    for (int i = 0; i < 16; ++i) a.in[i] = (const float*)d_in[i];
    a.out = (float*)d_out; a.ws = (unsigned char*)d_ws;
#if MK_SINGLE
    a.ph_lo = 0; a.ph_hi = NPHASES;
    void* kargs[] = {&a};
    hipError_t e = hipLaunchCooperativeKernel((const void*)fwd_megakernel, dim3(grid), dim3(NWAVES * 64), kargs, LDS_BYTES, stream);
    if (e != hipSuccess) fprintf(stderr, "kernel_launch: cooperative launch failed: %s (grid %d)\n", hipGetErrorString(e), grid);
#else
    for (int ph = 0; ph < NPHASES; ++ph) { a.ph_lo = ph; a.ph_hi = ph + 1; hipLaunchKernelGGL(fwd_megakernel, dim3(grid), dim3(NWAVES * 64), LDS_BYTES, stream, a); }
#endif
}
```
